# Optimizing an MI355X kernel written in HIP

```python
import math
import jax, jax.numpy as jnp
from jax import lax
import numpy as np

D_MODEL = 1024
BATCH = 2
SEQ = 8192
DEPTH = 1

HEAD_DIM = 64
N_HEADS_FOX = 8
N_HEADS_DIL = 8
D_FOX = N_HEADS_FOX * HEAD_DIM
D_DIL = N_HEADS_DIL * HEAD_DIM
D_MIX = D_FOX + D_DIL
D_PROJ = 3 * D_FOX + 3 * D_DIL + N_HEADS_FOX
DIL_PATTERNS = ((128, 1), (512, 4), (2048, 16))
BLOCK = 128
ROPE_THETA = 10000.0
N_GROUPS = 4
EXPERTS_PER_GROUP = 8
N_EXPERTS = N_GROUPS * EXPERTS_PER_GROUP
TOP_K_INNER = 2
D_EXPERT = 512
EPS = 1e-6
NEG = -1e30
FORGET_BIAS_INIT = 3.0

kernel_name = "hymba_fox_dilated_hmoe_block"


def rmsnorm(x, g):
    xf = x.astype(jnp.float32)
    y = xf * lax.rsqrt(jnp.mean(xf * xf, axis=-1, keepdims=True) + EPS)
    return (y * g.astype(jnp.float32)).astype(x.dtype)


def rope(x, pos):
    dh = x.shape[-1]
    inv_freq = 1.0 / (ROPE_THETA ** (jnp.arange(0, dh, 2, dtype=jnp.float32) / dh))
    ang = pos[:, None] * inv_freq[None, :]
    cos, sin = jnp.cos(ang), jnp.sin(ang)
    xf = x.astype(jnp.float32)
    x1, x2 = xf[..., : dh // 2], xf[..., dh // 2:]
    out = jnp.concatenate([x1 * cos - x2 * sin, x2 * cos + x1 * sin], axis=-1)
    return out.astype(x.dtype)


def forgetting_attention(q, k, v, logf):
    B, H, S, dh = q.shape
    scale = 1.0 / math.sqrt(dh)
    c = jnp.cumsum(logf, axis=-1)
    nb = S // BLOCK
    qb = q.reshape(B, H, nb, BLOCK, dh).transpose(2, 0, 1, 3, 4)
    cb = c.reshape(B, H, nb, BLOCK).transpose(2, 0, 1, 3)
    kpos = jnp.arange(S)

    def one_block(args):
        qi, ci, i = args
        s = jnp.einsum('bhqd,bhkd->bhqk', qi, k).astype(jnp.float32) * scale
        s = s + ci[..., None] - c[:, :, None, :]
        qpos = i * BLOCK + jnp.arange(BLOCK)
        mask = kpos[None, :] <= qpos[:, None]
        s = jnp.where(mask, s, NEG)
        p = jax.nn.softmax(s, axis=-1)
        return jnp.einsum('bhqk,bhkd->bhqd', p.astype(v.dtype), v)

    out = lax.map(one_block, (qb, cb, jnp.arange(nb)))
    return out.transpose(1, 2, 0, 3, 4).reshape(B, H, S, dh)


def dilated_branch(q, k, v, window, dilation):
    B, H, S, dh = q.shape
    scale = 1.0 / math.sqrt(dh)
    wsub = window // dilation
    unit = dilation * BLOCK
    Sp = -(-S // unit) * unit
    L = Sp // dilation
    nb = L // BLOCK
    pad = ((0, 0), (0, 0), (0, Sp - S), (0, 0))

    def split(t):
        t = jnp.pad(t, pad).reshape(B, H, L, dilation, dh).transpose(0, 1, 3, 2, 4)
        return t.reshape(B, H, dilation, nb, BLOCK, dh)

    def with_prev(t):
        prev = jnp.pad(t, ((0, 0), (0, 0), (0, 0), (1, 0), (0, 0), (0, 0)))[:, :, :, :-1]
        return jnp.concatenate([prev, t], axis=4)

    qs = split(q)
    kw = with_prev(split(k))
    vw = with_prev(split(v))
    s = jnp.einsum('bhrnqd,bhrnkd->bhrnqk', qs, kw).astype(jnp.float32) * scale
    ql = jnp.arange(BLOCK)[:, None]
    kl = jnp.arange(2 * BLOCK)[None, :]
    dist = ql + BLOCK - kl
    kpos = jnp.arange(nb)[:, None, None] * BLOCK + kl[None] - BLOCK
    valid = (dist >= 0) & (dist <= wsub) & (kpos >= 0)
    s = jnp.where(valid, s, NEG)
    m = jnp.max(s, axis=-1, keepdims=True)
    p = jnp.exp(s - m)
    l = jnp.sum(p, axis=-1, keepdims=True)
    o = jnp.einsum('bhrnqk,bhrnkd->bhrnqd', (p / l).astype(v.dtype), vw)
    lse = (m + jnp.log(l))[..., 0]
    o = o.reshape(B, H, dilation, L, dh).transpose(0, 1, 3, 2, 4).reshape(B, H, Sp, dh)[:, :, :S]
    lse = lse.reshape(B, H, dilation, L).transpose(0, 1, 3, 2).reshape(B, H, Sp)[:, :, :S]
    return o, lse


def dilated_attention(q, k, v):
    outs, lses = [], []
    for window, dilation in DIL_PATTERNS:
        o, lse = dilated_branch(q, k, v, window, dilation)
        outs.append(o)
        lses.append(lse)
    w = jax.nn.softmax(jnp.stack(lses, axis=0), axis=0)
    o = jnp.sum(w[..., None] * jnp.stack(outs, axis=0).astype(jnp.float32), axis=0)
    return o.astype(q.dtype)


def token_mixer(xn, w_in, b_forget, q_norm_fox, k_norm_fox, q_norm_dil, k_norm_dil,
                out_norm_fox, out_norm_dil, w_out):
    B, S, _ = xn.shape
    proj = xn @ w_in
    o1 = 3 * D_FOX
    o2 = o1 + 3 * D_DIL
    qa, ka, va = jnp.split(proj[..., :o1], 3, axis=-1)
    qb, kb, vb = jnp.split(proj[..., o1:o2], 3, axis=-1)
    fa = proj[..., o2:]

    def heads(t, h):
        return t.reshape(B, S, h, HEAD_DIM).transpose(0, 2, 1, 3)

    qa = rmsnorm(heads(qa, N_HEADS_FOX), q_norm_fox)
    ka = rmsnorm(heads(ka, N_HEADS_FOX), k_norm_fox)
    va = heads(va, N_HEADS_FOX)
    logf = jax.nn.log_sigmoid(fa.astype(jnp.float32) + b_forget.astype(jnp.float32))
    logf = logf.transpose(0, 2, 1)
    oa = forgetting_attention(qa, ka, va, logf)

    pos = jnp.arange(S, dtype=jnp.float32)
    qb = rope(rmsnorm(heads(qb, N_HEADS_DIL), q_norm_dil), pos)
    kb = rope(rmsnorm(heads(kb, N_HEADS_DIL), k_norm_dil), pos)
    vb = heads(vb, N_HEADS_DIL)
    ob = dilated_attention(qb, kb, vb)

    oa = rmsnorm(oa.transpose(0, 2, 1, 3).reshape(B, S, D_FOX), out_norm_fox)
    ob = rmsnorm(ob.transpose(0, 2, 1, 3).reshape(B, S, D_DIL), out_norm_dil)
    return jnp.concatenate([oa, ob], axis=-1) @ w_out


def hierarchical_moe(xn, w_router_group, b_router_group, w_router_expert, b_router_expert,
                     w_gate, w_up, w_down):
    B, S, D = xn.shape
    t = xn.reshape(B * S, D)
    zg = (t @ w_router_group).astype(jnp.float32) + b_router_group.astype(jnp.float32)
    pg = jax.nn.softmax(zg, axis=-1)
    pg_top, g_sel = lax.top_k(pg, 1)
    ze = jnp.einsum('td,gde->tge', t, w_router_expert).astype(jnp.float32)
    ze = ze + b_router_expert.astype(jnp.float32)
    ze_sel = jnp.take_along_axis(ze, g_sel[:, :, None], axis=1)[:, 0]
    v2, i2 = lax.top_k(ze_sel, TOP_K_INNER)
    gates = jax.nn.softmax(v2, axis=-1) * pg_top
    eid = g_sel * EXPERTS_PER_GROUP + i2
    combine = jnp.sum(jax.nn.one_hot(eid, N_EXPERTS, dtype=jnp.float32) * gates[..., None], axis=1)
    y = jnp.zeros((B * S, D), jnp.float32)
    for e in range(N_EXPERTS):
        h = jax.nn.silu(t @ w_gate[e]) * (t @ w_up[e])
        y = y + combine[:, e:e + 1] * (h @ w_down[e]).astype(jnp.float32)
    return y.astype(xn.dtype).reshape(B, S, D)


def setup_inputs(seed: int = 0) -> dict:
    key = jax.random.key(seed)
    ks = jax.random.split(key, 20)
    f32 = jnp.float32

    def nrm(k, shape, scale):
        return jax.random.normal(k, shape, f32) * scale

    def gain(k, shape):
        return 1.0 + 0.02 * jax.random.normal(k, shape, f32)

    return {
        "x": jax.random.normal(ks[0], (BATCH, SEQ, D_MODEL), f32),
        "norm_mix": gain(ks[1], (DEPTH, D_MODEL)),
        "w_in": nrm(ks[2], (DEPTH, D_MODEL, D_PROJ), D_MODEL ** -0.5),
        "b_forget": FORGET_BIAS_INIT + 0.1 * jax.random.normal(ks[3], (DEPTH, N_HEADS_FOX), f32),
        "q_norm_fox": gain(ks[4], (DEPTH, HEAD_DIM)),
        "k_norm_fox": gain(ks[5], (DEPTH, HEAD_DIM)),
        "q_norm_dil": gain(ks[6], (DEPTH, HEAD_DIM)),
        "k_norm_dil": gain(ks[7], (DEPTH, HEAD_DIM)),
        "out_norm_fox": gain(ks[8], (DEPTH, D_FOX)),
        "out_norm_dil": gain(ks[9], (DEPTH, D_DIL)),
        "w_out": nrm(ks[10], (DEPTH, D_MIX, D_MODEL), D_MIX ** -0.5),
        "norm_ffn": gain(ks[11], (DEPTH, D_MODEL)),
        "w_router_group": nrm(ks[12], (DEPTH, D_MODEL, N_GROUPS), D_MODEL ** -0.5),
        "b_router_group": nrm(ks[13], (DEPTH, N_GROUPS), 0.01),
        "w_router_expert": nrm(ks[14], (DEPTH, N_GROUPS, D_MODEL, EXPERTS_PER_GROUP), D_MODEL ** -0.5),
        "b_router_expert": nrm(ks[15], (DEPTH, N_GROUPS, EXPERTS_PER_GROUP), 0.01),
        "w_gate": nrm(ks[16], (DEPTH, N_EXPERTS, D_MODEL, D_EXPERT), D_MODEL ** -0.5),
        "w_up": nrm(ks[17], (DEPTH, N_EXPERTS, D_MODEL, D_EXPERT), D_MODEL ** -0.5),
        "w_down": nrm(ks[18], (DEPTH, N_EXPERTS, D_EXPERT, D_MODEL), D_EXPERT ** -0.5),
    }


def reference(x, norm_mix, w_in, b_forget, q_norm_fox, k_norm_fox, q_norm_dil, k_norm_dil,
              out_norm_fox, out_norm_dil, w_out, norm_ffn, w_router_group, b_router_group,
              w_router_expert, b_router_expert, w_gate, w_up, w_down):
    h = x
    for l in range(DEPTH):
        xn = rmsnorm(h, norm_mix[l])
        h = h + token_mixer(xn, w_in[l], b_forget[l], q_norm_fox[l], k_norm_fox[l],
                            q_norm_dil[l], k_norm_dil[l], out_norm_fox[l], out_norm_dil[l],
                            w_out[l])
        hn = rmsnorm(h, norm_ffn[l])
        h = h + hierarchical_moe(hn, w_router_group[l], b_router_group[l], w_router_expert[l],
                                 b_router_expert[l], w_gate[l], w_up[l], w_down[l])
    return h
```

```cpp
#include <hip/hip_runtime.h>
#include <stdint.h>
#include <math.h>

constexpr int D_MODEL = 1024, BATCH = 2, SEQ = 8192, NT = BATCH * SEQ;
constexpr int HD = 64, NH = 8, D_PROJ = 3080;
constexpr int NE = 32, D_EXP = 512;
constexpr float EPS = 1e-6f;

constexpr size_t MiB = 1u << 20;
constexpr size_t WS_CTL = 0;
constexpr size_t WS_ROPE = 1 * MiB;
constexpr size_t WS_C = 3 * MiB;
constexpr size_t WS_ROUTE = 4 * MiB;
constexpr size_t WS_PAIRTOK = 5 * MiB;
constexpr size_t WS_PAIRGATE = 6 * MiB;
constexpr size_t WS_XN = 8 * MiB;
constexpr size_t WS_PROJ = 72 * MiB;
constexpr size_t WS_END = 265 * MiB;
constexpr int CW_COUNT = 0;
constexpr int CW_OFFS = 64;
constexpr int CW_CURSOR = 128;

__device__ __forceinline__ float wave_sum(float v) {
#pragma unroll
    for (int o = 1; o < 64; o <<= 1) v += __shfl_xor(v, o);
    return v;
}
__device__ __forceinline__ float wave_max(float v) {
#pragma unroll
    for (int o = 1; o < 64; o <<= 1) v = fmaxf(v, __shfl_xor(v, o));
    return v;
}

__global__ void k_rope_table(float* cosT, float* sinT) {
    int idx = blockIdx.x * blockDim.x + threadIdx.x;
    if (idx >= SEQ * 32) return;
    int pos = idx >> 5, i = idx & 31;
    float inv_freq = 1.0f / exp2f(((float)(2 * i) / 64.0f) * 13.287712379549449f);
    float ang = (float)pos * inv_freq;
    double a = (double)ang;
    double k = rint(a * 0.15915494309189535);
    double r = a - k * 6.283185307179586;
    float rf = (float)r;
    cosT[idx] = cosf(rf); sinT[idx] = sinf(rf);
}

__global__ __launch_bounds__(256) void k_rmsnorm1024(const float* x, const float* g, float* out, int rows) {
    int row = blockIdx.x * 4 + (threadIdx.x >> 6), lane = threadIdx.x & 63;
    if (row >= rows) return;
    const float4* xr = (const float4*)(x + (size_t)row * 1024);
    float4 v[4]; float ss = 0.f;
#pragma unroll
    for (int j = 0; j < 4; ++j) { v[j] = xr[lane + 64 * j]; ss += v[j].x * v[j].x + v[j].y * v[j].y + v[j].z * v[j].z + v[j].w * v[j].w; }
    ss = wave_sum(ss);
    float rs = rsqrtf(ss * (1.0f / 1024.0f) + EPS);
    float4* o = (float4*)(out + (size_t)row * 1024);
#pragma unroll
    for (int j = 0; j < 4; ++j) { float4 gg = ((const float4*)g)[lane + 64 * j]; float4 r; r.x = v[j].x * rs * gg.x; r.y = v[j].y * rs * gg.y; r.z = v[j].z * rs * gg.z; r.w = v[j].w * rs * gg.w; o[lane + 64 * j] = r; }
}

struct GemmArgs {
    const float* A; long lda; const int* rowidx; const int* Mptr; long M; const float* B; long ldb; long N; long K;
    const int* offs; size_t bstride;
};
template <class Epi>
__global__ __launch_bounds__(256) void k_gemm_f32(GemmArgs g, Epi epi) {
    __shared__ float As[16][68];
    __shared__ float Bs[16][68];
    const int tid = threadIdx.x;
    int M = (int)g.M, rbase = 0; const float* B = g.B; const int z = blockIdx.z;
    if (g.offs) { rbase = g.offs[z]; M = g.offs[z + 1] - rbase; B += (size_t)z * g.bstride; }
    const int m0 = blockIdx.y * 64, n0 = blockIdx.x * 64;
    if (m0 >= M) return;
    const int ar = tid >> 2, ak = (tid & 3) * 4;
    const int arow = m0 + ar;
    const float* aptr = nullptr;
    if (arow < M) { int src = g.rowidx ? g.rowidx[rbase + arow] : (rbase + arow); aptr = g.A + (size_t)src * g.lda + ak; }
    const int bk = tid >> 4, bn = (tid & 15) * 4;
    const bool bok = (n0 + bn) < g.N;
    const float* bptr = B + (size_t)bk * g.ldb + n0 + bn;
    const int ty = tid >> 4, tx = tid & 15;
    float acc[4][4] = {};
    for (int k0 = 0; k0 < g.K; k0 += 16) {
        float4 av = aptr ? *(const float4*)(aptr + k0) : make_float4(0.f, 0.f, 0.f, 0.f);
        float4 bv = bok ? *(const float4*)(bptr + (size_t)k0 * g.ldb) : make_float4(0.f, 0.f, 0.f, 0.f);
        __syncthreads();
        As[ak + 0][ar] = av.x; As[ak + 1][ar] = av.y; As[ak + 2][ar] = av.z; As[ak + 3][ar] = av.w;
        *(float4*)&Bs[bk][bn] = bv;
        __syncthreads();
#pragma unroll
        for (int k = 0; k < 16; ++k) {
            float4 a = *(const float4*)&As[k][ty * 4];
            float4 b = *(const float4*)&Bs[k][tx * 4];
            float aa[4] = {a.x, a.y, a.z, a.w}, bb[4] = {b.x, b.y, b.z, b.w};
#pragma unroll
            for (int i = 0; i < 4; ++i)
#pragma unroll
                for (int j = 0; j < 4; ++j) acc[i][j] = fmaf(aa[i], bb[j], acc[i][j]);
        }
    }
#pragma unroll
    for (int i = 0; i < 4; ++i) {
        int r = m0 + ty * 4 + i; if (r >= M) continue;
#pragma unroll
        for (int j = 0; j < 4; ++j) { int c = n0 + tx * 4 + j; if (c < g.N) epi(z, rbase + r, c, acc[i][j]); }
    }
}
struct EpiStore { float* C; long ldc; __device__ void operator()(int, int r, int c, float v) const { C[(size_t)r * ldc + c] = v; } };
struct EpiResidual { const float* X; float* C; long ldc; __device__ void operator()(int, int r, int c, float v) const { C[(size_t)r * ldc + c] = X[(size_t)r * ldc + c] + v; } };
struct EpiSiluMul { float* H; long ldc; __device__ void operator()(int, int r, int c, float v) const { float gte = H[(size_t)r * ldc + c]; float s = gte / (1.0f + __expf(-gte)); H[(size_t)r * ldc + c] = s * v; } };
struct EpiScatterAdd { float* out; const int* pair_tok; const float* pair_gate; __device__ void operator()(int, int r, int c, float v) const { atomicAdd(out + (size_t)pair_tok[r] * 1024 + c, pair_gate[r] * v); } };

__global__ __launch_bounds__(256) void k_qknorm_rope(float* proj, const float* qnf, const float* knf, const float* qnd, const float* knd, const float* cosT, const float* sinT) {
    int tok = blockIdx.x * 4 + (threadIdx.x >> 6), lane = threadIdx.x & 63;
    int pos = tok % SEQ;
    float* row = proj + (size_t)tok * D_PROJ;
    for (int tsel = 0; tsel < 4; ++tsel) {
        const int base = (tsel == 0) ? 0 : (tsel == 1) ? 512 : (tsel == 2) ? 1536 : 2048;
        const float* gn = (tsel == 0) ? qnf : (tsel == 1) ? knf : (tsel == 2) ? qnd : knd;
        const float gl = gn[lane];
        for (int h = 0; h < NH; ++h) {
            float v = row[base + h * 64 + lane];
            float ss = wave_sum(v * v);
            float y = v * rsqrtf(ss * (1.0f / 64.0f) + EPS) * gl;
            if (tsel >= 2) {
                int i = lane & 31;
                float c = cosT[pos * 32 + i], s = sinT[pos * 32 + i];
                float other = __shfl_xor(y, 32);
                y = (lane < 32) ? (y * c - other * s) : (y * c + other * s);
            }
            row[base + h * 64 + lane] = y;
        }
    }
}

__global__ __launch_bounds__(64) void k_cumsum(const float* proj, const float* bf, float* c) {
    int bh = blockIdx.x, b = bh / NH, h = bh % NH, lane = threadIdx.x;
    const float bias = bf[h];
    double s = 0.0;
    for (int i = 0; i < 128; ++i) { int t = lane * 128 + i; float z = proj[(size_t)(b * SEQ + t) * D_PROJ + 3072 + h] + bias; float lf = fminf(z, 0.f) - log1pf(expf(-fabsf(z))); s += (double)lf; }
    double incl = s;
    for (int o = 1; o < 64; o <<= 1) { double n = __shfl_up(incl, o); if (lane >= o) incl += n; }
    double run = incl - s;
    for (int i = 0; i < 128; ++i) { int t = lane * 128 + i; float z = proj[(size_t)(b * SEQ + t) * D_PROJ + 3072 + h] + bias; float lf = fminf(z, 0.f) - log1pf(expf(-fabsf(z))); run += (double)lf; c[bh * SEQ + t] = (float)run; }
}

__global__ __launch_bounds__(512) void k_fox_naive(const float* proj, const float* c, float* A2) {
    __shared__ float Ks[64][65];
    __shared__ float Vs[64][64];
    const int bh = blockIdx.y, b = bh / NH, h = bh % NH, t0 = blockIdx.x * 8;
    const int tid = threadIdx.x, wave = tid >> 6, lane = tid & 63, t = t0 + wave;
    const float qv = proj[(size_t)(b * SEQ + t) * D_PROJ + 0 + h * 64 + lane] * 0.125f;
    const float ct = c[bh * SEQ + t];
    float m = -INFINITY, l = 0.f, o = 0.f;
    const int ntiles = (t0 + 7) / 64 + 1;
    for (int jt = 0; jt < ntiles; ++jt) {
        __syncthreads();
        for (int i = 0; i < 8; ++i) { int idx = tid + i * 512, r = idx >> 6, d = idx & 63; size_t off = (size_t)(b * SEQ + jt * 64 + r) * D_PROJ + h * 64 + d; Ks[r][d] = proj[off + 512]; Vs[r][d] = proj[off + 1024]; }
        __syncthreads();
        const int s = jt * 64 + lane;
        float sc = 0.f;
#pragma unroll
        for (int d = 0; d < 64; ++d) sc = fmaf(__shfl(qv, d), Ks[lane][d], sc);
        sc += ct - c[bh * SEQ + s];
        const bool valid = s <= t;
        sc = valid ? sc : -INFINITY;
        float mn = fmaxf(m, wave_max(sc));
        float p = valid ? __expf(sc - mn) : 0.f;
        float alpha = __expf(m - mn);
        l = l * alpha + wave_sum(p); o *= alpha;
#pragma unroll
        for (int k = 0; k < 64; ++k) o = fmaf(__shfl(p, k), Vs[k][lane], o);
        m = mn;
    }
    A2[(size_t)(b * SEQ + t) * 1024 + h * 64 + lane] = o / l;
}

__global__ __launch_bounds__(256) void k_dil_naive(const float* proj, float* A2) {
    const int wave = threadIdx.x >> 6, lane = threadIdx.x & 63;
    const int idx = blockIdx.x * 4 + wave;
    const int h = idx & 7, tok = idx >> 3, b = tok / SEQ, t = tok % SEQ;
    const float* qrow = proj + (size_t)tok * D_PROJ + 1536 + h * 64;
    const float qv = qrow[lane] * 0.125f;
    float sc[9]; int sp[9];
    float mx = -INFINITY;
#pragma unroll
    for (int p = 0; p < 3; ++p) {
        const int d = (p == 0) ? 1 : (p == 1) ? 4 : 16;
        const int jmax = min(128, t / d);
#pragma unroll
        for (int r = 0; r < 3; ++r) {
            const int j = r * 64 + lane; const bool valid = j <= jmax; const int s = valid ? t - d * j : t;
            const float* krow = proj + (size_t)(b * SEQ + s) * D_PROJ + 2048 + h * 64;
            float a = 0.f;
#pragma unroll
            for (int q4 = 0; q4 < 16; ++q4) { float4 kv = *(const float4*)(krow + q4 * 4);
                a = fmaf(__shfl(qv, q4 * 4 + 0), kv.x, a); a = fmaf(__shfl(qv, q4 * 4 + 1), kv.y, a); a = fmaf(__shfl(qv, q4 * 4 + 2), kv.z, a); a = fmaf(__shfl(qv, q4 * 4 + 3), kv.w, a); }
            sc[p * 3 + r] = valid ? a : -INFINITY; sp[p * 3 + r] = s; mx = fmaxf(mx, sc[p * 3 + r]);
        }
    }
    mx = wave_max(mx);
    float l = 0.f;
#pragma unroll
    for (int i = 0; i < 9; ++i) { sc[i] = __expf(sc[i] - mx); l += sc[i]; }
    l = wave_sum(l);
    float o = 0.f;
#pragma unroll
    for (int i = 0; i < 9; ++i) {
        const int kmax = (i % 3 == 2) ? 1 : 64;
        for (int k = 0; k < kmax; ++k) { float pk = __shfl(sc[i], k); int sk = __shfl(sp[i], k); o = fmaf(pk, proj[(size_t)(b * SEQ + sk) * D_PROJ + 2560 + h * 64 + lane], o); }
    }
    A2[(size_t)tok * 1024 + 512 + h * 64 + lane] = o / l;
}

__global__ __launch_bounds__(256) void k_outnorm(float* A2, const float* gf, const float* gd) {
    int tok = blockIdx.x * 4 + (threadIdx.x >> 6), lane = threadIdx.x & 63;
    float* row = A2 + (size_t)tok * 1024;
    for (int half = 0; half < 2; ++half) {
        const float* g = half ? gd : gf;
        float v[8]; float ss = 0.f;
#pragma unroll
        for (int j = 0; j < 8; ++j) { v[j] = row[half * 512 + lane + 64 * j]; ss += v[j] * v[j]; }
        ss = wave_sum(ss);
        float rs = rsqrtf(ss * (1.0f / 512.0f) + EPS);
#pragma unroll
        for (int j = 0; j < 8; ++j) row[half * 512 + lane + 64 * j] = v[j] * rs * g[lane + 64 * j];
    }
}

__global__ __launch_bounds__(256) void k_router(const float* h, const float* gffn, const float* wrg, const float* brg, const float* wre, const float* bre,
                                                float* hn, int* route_e, float* route_g, int* counts) {
    int tok = blockIdx.x * 4 + (threadIdx.x >> 6), lane = threadIdx.x & 63;
    const float* xr = h + (size_t)tok * 1024;
    float v[16]; float ss = 0.f;
#pragma unroll
    for (int j = 0; j < 16; ++j) { v[j] = xr[lane + 64 * j]; ss += v[j] * v[j]; }
    ss = wave_sum(ss);
    float rs = rsqrtf(ss * (1.0f / 1024.0f) + EPS);
#pragma unroll
    for (int j = 0; j < 16; ++j) { v[j] = v[j] * rs * gffn[lane + 64 * j]; hn[(size_t)tok * 1024 + lane + 64 * j] = v[j]; }
    float zg[4];
#pragma unroll
    for (int g = 0; g < 4; ++g) { float a = 0.f;
#pragma unroll
        for (int j = 0; j < 16; ++j) a = fmaf(v[j], wrg[(size_t)(lane + 64 * j) * 4 + g], a);
        zg[g] = wave_sum(a) + brg[g]; }
    int gs = 0; float zm = zg[0];
#pragma unroll
    for (int g = 1; g < 4; ++g) if (zg[g] > zm) { zm = zg[g]; gs = g; }
    float den = 0.f;
#pragma unroll
    for (int g = 0; g < 4; ++g) den += expf(zg[g] - zm);
    const float pg_top = 1.0f / den;
    float ze[8];
#pragma unroll
    for (int e = 0; e < 8; ++e) { float a = 0.f;
#pragma unroll
        for (int j = 0; j < 16; ++j) a = fmaf(v[j], wre[((size_t)gs * 1024 + lane + 64 * j) * 8 + e], a);
        ze[e] = wave_sum(a) + bre[gs * 8 + e]; }
    int i1 = 0; float v1 = ze[0];
#pragma unroll
    for (int e = 1; e < 8; ++e) if (ze[e] > v1) { v1 = ze[e]; i1 = e; }
    int i2 = -1; float v2 = -INFINITY;
#pragma unroll
    for (int e = 0; e < 8; ++e) if (e != i1 && ze[e] > v2) { v2 = ze[e]; i2 = e; }
    const float e2 = expf(v2 - v1); const float g1 = pg_top / (1.0f + e2), g2 = pg_top * e2 / (1.0f + e2);
    if (lane == 0) { route_e[tok * 2] = gs * 8 + i1; route_e[tok * 2 + 1] = gs * 8 + i2; route_g[tok * 2] = g1; route_g[tok * 2 + 1] = g2;
        atomicAdd(counts + gs * 8 + i1, 1); atomicAdd(counts + gs * 8 + i2, 1); }
}
__global__ void k_offsets(const int* counts, int* offs) { if (threadIdx.x == 0) { int a = 0; for (int e = 0; e < NE; ++e) { offs[e] = a; a += counts[e]; } offs[NE] = a; } }
__global__ void k_scatter(const int* route_e, const float* route_g, const int* offs, int* cursor, int* pair_tok, float* pair_gate) {
    int tok = blockIdx.x * blockDim.x + threadIdx.x; if (tok >= NT) return;
    for (int s = 0; s < 2; ++s) { int e = route_e[tok * 2 + s]; int slot = offs[e] + atomicAdd(cursor + e, 1); pair_tok[slot] = tok; pair_gate[slot] = route_g[tok * 2 + s]; }
}

extern "C" void kernel_launch(void* const* d_in, const int* in_sizes, int n_in, void* d_out, int out_size, void* d_ws, size_t ws_size, hipStream_t stream) {
    const float* x = (const float*)d_in[0]; const float* norm_mix = (const float*)d_in[1]; const float* w_in = (const float*)d_in[2]; const float* b_forget = (const float*)d_in[3];
    const float* qnf = (const float*)d_in[4]; const float* knf = (const float*)d_in[5]; const float* qnd = (const float*)d_in[6]; const float* knd = (const float*)d_in[7];
    const float* onf = (const float*)d_in[8]; const float* ond = (const float*)d_in[9]; const float* w_out = (const float*)d_in[10]; const float* norm_ffn = (const float*)d_in[11];
    const float* wrg = (const float*)d_in[12]; const float* brg = (const float*)d_in[13]; const float* wre = (const float*)d_in[14]; const float* bre = (const float*)d_in[15];
    const float* w_gate = (const float*)d_in[16]; const float* w_up = (const float*)d_in[17]; const float* w_down = (const float*)d_in[18];
    float* out = (float*)d_out; char* ws = (char*)d_ws;
    if (ws_size < WS_END) return;
    int* ctl = (int*)(ws + WS_CTL); float* cosT = (float*)(ws + WS_ROPE); float* sinT = cosT + SEQ * 32; float* cc = (float*)(ws + WS_C);
    int* route_e = (int*)(ws + WS_ROUTE); float* route_g = (float*)(ws + WS_ROUTE + 128 * 1024);
    int* pair_tok = (int*)(ws + WS_PAIRTOK); float* pair_gate = (float*)(ws + WS_PAIRGATE);
    float* XN = (float*)(ws + WS_XN); float* A2 = XN; float* proj = (float*)(ws + WS_PROJ); float* HN = proj; float* HMID = (float*)(ws + WS_PROJ + 64 * MiB);
    (void)hipMemsetAsync(ws + WS_CTL, 0, 4096, stream);
    k_rope_table<<<SEQ * 32 / 256, 256, 0, stream>>>(cosT, sinT);
    k_rmsnorm1024<<<NT / 4, 256, 0, stream>>>(x, norm_mix, XN, NT);
    { GemmArgs g{XN, 1024, nullptr, nullptr, NT, w_in, D_PROJ, D_PROJ, 1024, nullptr, 0}; k_gemm_f32<<<dim3((D_PROJ + 63) / 64, NT / 64, 1), 256, 0, stream>>>(g, EpiStore{proj, D_PROJ}); }
    k_qknorm_rope<<<NT / 4, 256, 0, stream>>>(proj, qnf, knf, qnd, knd, cosT, sinT);
    k_cumsum<<<16, 64, 0, stream>>>(proj, b_forget, cc);
    k_fox_naive<<<dim3(SEQ / 8, 16), 512, 0, stream>>>(proj, cc, A2);
    k_dil_naive<<<NT * 8 / 4, 256, 0, stream>>>(proj, A2);
    k_outnorm<<<NT / 4, 256, 0, stream>>>(A2, onf, ond);
    { GemmArgs g{A2, 1024, nullptr, nullptr, NT, w_out, 1024, 1024, 1024, nullptr, 0}; k_gemm_f32<<<dim3(16, NT / 64, 1), 256, 0, stream>>>(g, EpiResidual{x, out, 1024}); }
    k_router<<<NT / 4, 256, 0, stream>>>(out, norm_ffn, wrg, brg, wre, bre, HN, route_e, route_g, ctl + CW_COUNT);
    k_offsets<<<1, 64, 0, stream>>>(ctl + CW_COUNT, ctl + CW_OFFS);
    k_scatter<<<NT / 256, 256, 0, stream>>>(route_e, route_g, ctl + CW_OFFS, ctl + CW_CURSOR, pair_tok, pair_gate);
    { GemmArgs g{HN, 1024, pair_tok, nullptr, 0, w_gate, 512, 512, 1024, ctl + CW_OFFS, (size_t)1024 * 512}; k_gemm_f32<<<dim3(8, 256, NE), 256, 0, stream>>>(g, EpiStore{HMID, 512}); }
    { GemmArgs g{HN, 1024, pair_tok, nullptr, 0, w_up, 512, 512, 1024, ctl + CW_OFFS, (size_t)1024 * 512}; k_gemm_f32<<<dim3(8, 256, NE), 256, 0, stream>>>(g, EpiSiluMul{HMID, 512}); }
    { GemmArgs g{HMID, 512, nullptr, nullptr, 0, w_down, 1024, 1024, 512, ctl + CW_OFFS, (size_t)512 * 1024}; k_gemm_f32<<<dim3(16, 256, NE), 256, 0, stream>>>(g, EpiScatterAdd{out, pair_tok, pair_gate}); }
}
```

```cpp
#include <hip/hip_runtime.h>
#include <stdint.h>
#include <math.h>
#include <cstdio>

constexpr int D_MODEL = 1024, BATCH = 2, SEQ = 8192, NT = BATCH * SEQ;
constexpr int HD = 64, NH = 8, D_PROJ = 3080, NQKV = 3072;
constexpr int NE = 32, D_EXP = 512;
constexpr float EPS = 1e-6f;
constexpr float LOG2E = 1.4426950408889634f;
constexpr float QSCALE = 0.125f * LOG2E;

constexpr size_t MiB = 1u << 20, KiB = 1024;
constexpr size_t WS_CTL = 0, CTL_ZERO_BYTES = 128 * KiB;
constexpr size_t WS_GTAB = 256 * KiB;
constexpr size_t WS_LOGF = 512 * KiB;
constexpr size_t WS_ROPE = 1 * MiB;
constexpr size_t WS_CB = 3 * MiB;
constexpr size_t WS_ROUTE = 3 * MiB + 512 * KiB;
constexpr size_t WS_LSE = 4 * MiB + 512 * KiB;
constexpr size_t WS_WIN = 6 * MiB;
constexpr size_t WS_WO = 12 * MiB;
constexpr size_t WS_WGU = 14 * MiB;
constexpr size_t WS_WD = 78 * MiB;
constexpr size_t WS_XN = 110 * MiB;
constexpr size_t WS_QKV = 142 * MiB;
constexpr size_t QKV_TSTRIDE = (size_t)NT * 512;
constexpr size_t WS_A2 = 238 * MiB;
constexpr size_t WS_END = 270 * MiB;
namespace pg8 {
#define PG8_LAS __attribute__((address_space(3)))
typedef unsigned short bf16_t;
typedef short bf16x8 __attribute__((ext_vector_type(8)));
typedef float f32x4 __attribute__((ext_vector_type(4)));
typedef unsigned u32x4 __attribute__((ext_vector_type(4)));
constexpr int BM = 256, BK = 64, HALF = 128, HTB = HALF * BK * 2  , STAGE_BYTES = 8 * HTB, NXCD = 8, WGM = 8;

__host__ __device__ __forceinline__ int lds_byte(int r, int c) { const int st = (r >> 4) * 2 + (c >> 5), rr = r & 15, cc = c & 31, ob = rr * 64 + cc * 2; return st * 1024 + (ob ^ (((ob >> 9) & 1) << 5)); }
__host__ __device__ __forceinline__ void stage_rc(int b, int& R, int& C) { const int st = b / 1024, sb = b % 1024, swz = sb ^ (((sb >> 9) & 1) << 5); R = (st >> 1) * 16 + swz / 64; C = (st & 1) * 32 + (swz % 64) / 2; }
__host__ __device__ __forceinline__ int perm32(int rho) { const int n = rho >> 4, i = rho & 15; return 8 * (i >> 2) + 4 * n + (i & 3); }

struct Unit { int pm, pn; };
struct Gemm { const bf16_t* A; const bf16_t* Bt; int M, N, K; };

struct StaticOrder {
    int nM, nN, nwg, G, c;
    __host__ __device__ void init(int M, int N, int G_, int c_) { nM = M / BM; nN = N / BM; nwg = nM * nN; G = G_; c = c_; }
    __host__ __device__ bool next(int i, Unit& u) const {
        const long L = (long)i * G + c; if (L >= nwg) return false;
        int wgid = (int)L; { const int q = nwg / NXCD, r = nwg % NXCD, xcd = wgid % NXCD, off = wgid / NXCD; wgid = (xcd < r ? xcd * (q + 1) : r * (q + 1) + (xcd - r) * q) + off; }
        const int nig = WGM * nN, gid = wgid / nig, fm = gid * WGM, gsz = (nM - fm) < WGM ? (nM - fm) : WGM;
        u.pm = fm + ((wgid % nig) % gsz); u.pn = (wgid % nig) / gsz; return true;
    }
    __device__ __forceinline__ void a_ready(const Unit&) const {}
    __device__ __forceinline__ void done(const Unit&) const {}
};

__device__ __forceinline__ unsigned cvt_pk_bf16(float lo, float hi) { unsigned r; asm volatile("v_cvt_pk_bf16_f32 %0, %1, %2" : "=v"(r) : "v"(lo), "v"(hi)); return r; }

struct EpiQKV {
    static constexpr bool PERM = true, AFTER_DRAIN = false;
    bf16_t* qkv; const float* gtab; const float* cosT; const float* sinT;
    __device__ __forceinline__ void operator()(const f32x4 (&acc)[2][2][4][2], const Unit& u, int wr, int wc, int fr, int fq) const {
        const int tt = u.pn >> 1, head = (u.pn & 1) * 4 + wc;
        bf16_t* T = qkv + (size_t)tt * QKV_TSTRIDE + head * 64 + 8 * fq;
        const bool nrm = (tt != 2 && tt != 5), rope = (tt == 3 || tt == 4);
        f32x4 gv[2][2];
#pragma unroll
        for (int bj = 0; bj < 2; ++bj)
#pragma unroll
            for (int n = 0; n < 2; ++n) gv[bj][n] = (f32x4){1.f, 1.f, 1.f, 1.f};
        if (nrm) { const int gi = (tt == 0) ? 0 : (tt == 1) ? 1 : (tt == 3) ? 2 : 3; const float* g = gtab + gi * 64;
#pragma unroll
            for (int bj = 0; bj < 2; ++bj)
#pragma unroll
                for (int n = 0; n < 2; ++n) gv[bj][n] = *(const f32x4*)(g + 32 * bj + 8 * fq + 4 * n); }
#pragma unroll
        for (int ai = 0; ai < 2; ++ai)
#pragma unroll
            for (int m = 0; m < 4; ++m) {
                const int row = u.pm * BM + ai * HALF + wr * 64 + m * 16 + fr;
                f32x4 v[2][2];
#pragma unroll
                for (int bj = 0; bj < 2; ++bj)
#pragma unroll
                    for (int n = 0; n < 2; ++n) v[bj][n] = acc[ai][bj][m][n];
                if (nrm) {
                    float ss = 0.f;
#pragma unroll
                    for (int bj = 0; bj < 2; ++bj)
#pragma unroll
                        for (int n = 0; n < 2; ++n) { const f32x4 x = v[bj][n]; ss += (x[0] * x[0] + x[1] * x[1]) + (x[2] * x[2] + x[3] * x[3]); }
                    ss += __shfl_xor(ss, 16); ss += __shfl_xor(ss, 32);
                    const float rs = __builtin_amdgcn_rsqf(ss * (1.0f / 64.0f) + EPS);
#pragma unroll
                    for (int bj = 0; bj < 2; ++bj)
#pragma unroll
                        for (int n = 0; n < 2; ++n) v[bj][n] = v[bj][n] * rs * gv[bj][n];
                }
                if (rope) {
                    const int pos = row & (SEQ - 1);
#pragma unroll
                    for (int n = 0; n < 2; ++n) {
                        const f32x4 c = *(const f32x4*)(cosT + pos * 32 + 8 * fq + 4 * n), s = *(const f32x4*)(sinT + pos * 32 + 8 * fq + 4 * n);
                        const f32x4 x1 = v[0][n], x2 = v[1][n];
                        v[0][n] = x1 * c - x2 * s; v[1][n] = x2 * c + x1 * s;
                    }
                }
#pragma unroll
                for (int bj = 0; bj < 2; ++bj) { u32x4 w; w.x = cvt_pk_bf16(v[bj][0][0], v[bj][0][1]); w.y = cvt_pk_bf16(v[bj][0][2], v[bj][0][3]); w.z = cvt_pk_bf16(v[bj][1][0], v[bj][1][1]); w.w = cvt_pk_bf16(v[bj][1][2], v[bj][1][3]);
                    *(u32x4*)(T + (size_t)row * 512 + 32 * bj) = w; }
            }
    }
};
struct EpiRes {
    static constexpr bool PERM = false, AFTER_DRAIN = false;
    const float* X; float* out;
    __device__ __forceinline__ void operator()(const f32x4 (&acc)[2][2][4][2], const Unit& u, int wr, int wc, int fr, int fq) const {
        const int col0 = u.pn * BM + wc * 32 + 4 * fq;
#pragma unroll
        for (int ai = 0; ai < 2; ++ai)
#pragma unroll
            for (int m = 0; m < 4; ++m) { const size_t off = (size_t)(u.pm * BM + ai * HALF + wr * 64 + m * 16 + fr) * D_MODEL + col0;
#pragma unroll
                for (int bj = 0; bj < 2; ++bj)
#pragma unroll
                    for (int n = 0; n < 2; ++n) { const f32x4 xv = *(const f32x4*)(X + off + bj * HALF + n * 16); *(f32x4*)(out + off + bj * HALF + n * 16) = xv + acc[ai][bj][m][n]; } }
    }
};
template <class Epi, class Sched, bool ALIGN_EPI = false, bool SP2 = false>
__device__ __forceinline__ void gemm_phase(PG8_LAS unsigned char* lds, const Gemm g, const Sched& S, const Epi& E) {
    int tid_ = threadIdx.x; asm volatile("" : "+v"(tid_)); const int tid = tid_, wid = __builtin_amdgcn_readfirstlane(tid >> 6), lane = tid & 63, wr = wid >> 2, wc = wid & 3, fr = lane & 15, fq = lane >> 4;
    const int K = g.K, nt = K / BK;
    unsigned voffA[2], voffB[2];
#pragma unroll
    for (int i = 0; i < 2; ++i) { int R, C; stage_rc(tid * 16 + i * 8192, R, C); const int Rb = Epi::PERM ? ((R & ~31) + perm32(R & 31)) : R;
        voffA[i] = (unsigned)(R * K + C) * 2u; voffB[i] = (unsigned)(Rb * K + C) * 2u; }
    const size_t kstep = (size_t)(BK * 2);
    const size_t hstep = (size_t)HALF * K * 2;
    const size_t tstep = 2 * hstep;
    const unsigned ldsw = (unsigned)wid * 1024u;
    const int aoff = lds_byte(wr * 64 + fr, fq * 8), boff = lds_byte(wc * 32 + fr, fq * 8);
#define PG8_SA(b, h) (((b) * 2 + (h)) * HTB)
#define PG8_SB(b, h) ((4 + (b) * 2 + (h)) * HTB)
#define PG8_STAGE(bufoff, gbase, voff) do { _Pragma("unroll") for (int _i = 0; _i < 2; ++_i) \
        __builtin_amdgcn_global_load_lds((const unsigned*)((const char*)(gbase) + (voff)[_i]), (PG8_LAS unsigned*)(lds + (bufoff) + ldsw + _i * 8192), 16, 0, 0); } while (0)
#define PG8_LDA(dst, b, h) do { _Pragma("unroll") for (int m = 0; m < 4; ++m) _Pragma("unroll") for (int k = 0; k < 2; ++k) dst[m][k] = *(const PG8_LAS bf16x8*)(lds + PG8_SA(b, h) + aoff + m * 2048 + k * 1024); } while (0)
#define PG8_LDB(dst, b, h) do { _Pragma("unroll") for (int n = 0; n < 2; ++n) _Pragma("unroll") for (int k = 0; k < 2; ++k) dst[n][k] = *(const PG8_LAS bf16x8*)(lds + PG8_SB(b, h) + boff + n * 2048 + k * 1024); } while (0)
#define PG8_MMA(ai, bj, At, Bt) do { __builtin_amdgcn_s_setprio(1); _Pragma("unroll") for (int m = 0; m < 4; ++m) _Pragma("unroll") for (int n = 0; n < 2; ++n) _Pragma("unroll") for (int k = 0; k < 2; ++k) \
        acc[ai][bj][m][n] = __builtin_amdgcn_mfma_f32_16x16x32_bf16(Bt[n][k], At[m][k], acc[ai][bj][m][n], 0, 0, 0); __builtin_amdgcn_s_setprio(0); } while (0)
#define PG8_WAIT_V(n) asm volatile("s_waitcnt vmcnt(" #n ")" ::: "memory")
#define PG8_WAIT_L(n) asm volatile("s_waitcnt lgkmcnt(" #n ")" ::: "memory")
#define PG8_BAR __builtin_amdgcn_s_barrier()
#define PG8_SCHED __builtin_amdgcn_sched_barrier(0)
    Unit cur, nxt; int ui = 0;
    if (!S.next(0, cur)) return;
    f32x4 acc[2][2][4][2];
#pragma unroll
    for (int a = 0; a < 2; ++a)
#pragma unroll
        for (int b = 0; b < 2; ++b)
#pragma unroll
            for (int m = 0; m < 4; ++m)
#pragma unroll
                for (int n = 0; n < 2; ++n) acc[a][b][m][n] = (f32x4){0.f, 0.f, 0.f, 0.f};
    bf16x8 At[4][2], B0[2][2], B1[2][2];
    const char* cA = (const char*)g.A + (size_t)cur.pm * tstep; const char* cB = (const char*)g.Bt + (size_t)cur.pn * tstep;
    S.a_ready(cur);
    if constexpr (SP2) {
        PG8_STAGE(PG8_SB(0, 0), cB, voffB); PG8_STAGE(PG8_SB(0, 1), cB + hstep, voffB); PG8_STAGE(PG8_SA(0, 0), cA, voffA); PG8_STAGE(PG8_SA(0, 1), cA + hstep, voffA);
        if (wr == 1) PG8_BAR;
        PG8_WAIT_V(2); PG8_BAR;
        PG8_STAGE(PG8_SB(1, 0), cB + kstep, voffB); PG8_STAGE(PG8_SA(1, 0), cA + kstep, voffA); PG8_STAGE(PG8_SB(1, 1), cB + hstep + kstep, voffB);
        PG8_WAIT_V(6); PG8_BAR;
    } else {
        PG8_STAGE(PG8_SB(0, 0), cB, voffB); PG8_STAGE(PG8_SA(0, 0), cA, voffA); PG8_STAGE(PG8_SB(0, 1), cB + hstep, voffB); PG8_STAGE(PG8_SA(0, 1), cA + hstep, voffA);
        if (wr == 1) PG8_BAR;
        PG8_WAIT_V(4); PG8_BAR;
        PG8_STAGE(PG8_SB(1, 0), cB + kstep, voffB); PG8_STAGE(PG8_SA(1, 0), cA + kstep, voffA); PG8_STAGE(PG8_SB(1, 1), cB + hstep + kstep, voffB);
        PG8_WAIT_V(6); PG8_BAR;
    }
    for (;;) {
        const bool has_next = S.next(ui + 1, nxt);
        const char* nA = has_next ? (const char*)g.A + (size_t)nxt.pm * tstep : cA; const char* nB = has_next ? (const char*)g.Bt + (size_t)nxt.pn * tstep : cB;
        for (int t = 0; t < nt; t += 2) {
            const bool last = (t == nt - 2);
            const char* a1 = cA + (size_t)(t + 1) * kstep;
            const char* a2 = last ? nA : cA + (size_t)(t + 2) * kstep; const char* b2 = last ? nB : cB + (size_t)(t + 2) * kstep;
            const char* a3 = a2 + kstep; const char* b3 = b2 + kstep;
            if (last && has_next) S.a_ready(nxt);
            if constexpr (SP2) {
            PG8_LDB(B0, 0, 0); PG8_LDB(B1, 0, 1); PG8_SCHED; PG8_LDA(At, 0, 0); PG8_STAGE(PG8_SA(1, 1), a1 + hstep, voffA);
            PG8_WAIT_V(8); PG8_WAIT_L(0); PG8_BAR; PG8_MMA(0, 0, At, B0); PG8_MMA(0, 1, At, B1); PG8_BAR; PG8_SCHED;
            PG8_LDA(At, 0, 1); PG8_STAGE(PG8_SB(0, 0), b2, voffB); PG8_STAGE(PG8_SB(0, 1), b2 + hstep, voffB); PG8_STAGE(PG8_SA(0, 0), a2, voffA);
            PG8_WAIT_V(8); PG8_WAIT_L(0); PG8_BAR; PG8_MMA(1, 0, At, B0); PG8_MMA(1, 1, At, B1); PG8_BAR; PG8_SCHED;
            PG8_LDB(B0, 1, 0); PG8_LDB(B1, 1, 1); PG8_SCHED; PG8_LDA(At, 1, 0); PG8_STAGE(PG8_SA(0, 1), a2 + hstep, voffA);
            PG8_WAIT_V(8); PG8_WAIT_L(0); PG8_BAR; PG8_MMA(0, 0, At, B0); PG8_MMA(0, 1, At, B1); PG8_BAR; PG8_SCHED;
            PG8_LDA(At, 1, 1); PG8_STAGE(PG8_SB(1, 0), b3, voffB); PG8_STAGE(PG8_SB(1, 1), b3 + hstep, voffB); PG8_STAGE(PG8_SA(1, 0), a3, voffA);
            PG8_WAIT_V(8); PG8_WAIT_L(0); PG8_BAR; PG8_MMA(1, 0, At, B0); PG8_MMA(1, 1, At, B1); PG8_BAR; PG8_SCHED;
            } else {
            PG8_LDB(B0, 0, 0); PG8_SCHED; PG8_LDA(At, 0, 0); PG8_STAGE(PG8_SA(1, 1), a1 + hstep, voffA);
            PG8_WAIT_L(8); PG8_BAR; PG8_WAIT_L(0); PG8_MMA(0, 0, At, B0); PG8_BAR; PG8_SCHED;
            PG8_LDB(B1, 0, 1); PG8_STAGE(PG8_SB(0, 0), b2, voffB);
            PG8_BAR; PG8_WAIT_L(0); PG8_MMA(0, 1, At, B1); PG8_BAR;
            PG8_LDA(At, 0, 1); PG8_STAGE(PG8_SA(0, 0), a2, voffA);
            PG8_BAR; PG8_WAIT_L(0); PG8_MMA(1, 0, At, B0); PG8_BAR; PG8_SCHED;
            PG8_STAGE(PG8_SB(0, 1), b2 + hstep, voffB);
            PG8_WAIT_V(6); PG8_BAR; PG8_MMA(1, 1, At, B1); PG8_BAR;
            PG8_LDB(B0, 1, 0); PG8_SCHED; PG8_LDA(At, 1, 0); PG8_STAGE(PG8_SA(0, 1), a2 + hstep, voffA);
            PG8_WAIT_L(8); PG8_BAR; PG8_WAIT_L(0); PG8_MMA(0, 0, At, B0); PG8_BAR; PG8_SCHED;
            PG8_LDB(B1, 1, 1); PG8_STAGE(PG8_SB(1, 0), b3, voffB);
            PG8_BAR; PG8_WAIT_L(0); PG8_MMA(0, 1, At, B1); PG8_BAR;
            PG8_LDA(At, 1, 1); PG8_STAGE(PG8_SA(1, 0), a3, voffA);
            PG8_BAR; PG8_WAIT_L(0); PG8_MMA(1, 0, At, B0); PG8_BAR; PG8_SCHED;
            PG8_STAGE(PG8_SB(1, 1), b3 + hstep, voffB);
            PG8_WAIT_V(6); PG8_BAR; PG8_MMA(1, 1, At, B1); PG8_BAR;
            }
        }
        if constexpr (ALIGN_EPI) { if (wr == 0) PG8_BAR; }
        if constexpr (!Epi::AFTER_DRAIN) { E(acc, cur, wr, wc, fr, fq); S.done(cur); }
        if (!has_next) break;
#pragma unroll
        for (int a = 0; a < 2; ++a)
#pragma unroll
            for (int b = 0; b < 2; ++b)
#pragma unroll
                for (int m = 0; m < 4; ++m)
#pragma unroll
                    for (int n = 0; n < 2; ++n) acc[a][b][m][n] = (f32x4){0.f, 0.f, 0.f, 0.f};
        cur = nxt; cA = nA; cB = nB; ++ui;
        if constexpr (ALIGN_EPI) { if (wr == 1) PG8_BAR; }
    }
    PG8_WAIT_V(0);
    if constexpr (!ALIGN_EPI) { if (wr == 0) PG8_BAR; }
    PG8_BAR;
    if constexpr (Epi::AFTER_DRAIN) { E.fused(acc, cur, wr, wc, fr, fq, lds, wid, lane); S.done(cur); }
#undef PG8_SA
#undef PG8_SB
#undef PG8_STAGE
#undef PG8_LDA
#undef PG8_LDB
#undef PG8_MMA
#undef PG8_WAIT_V
#undef PG8_WAIT_L
#undef PG8_BAR
#undef PG8_SCHED
}
}
namespace pg8 {
template <class Epi, class Sched, class Src>
__device__ __forceinline__ void gemm_phase2(PG8_LAS unsigned char* lds, const Sched& S, const Src& X, const Epi& E) {
    typedef typename Sched::UnitT UnitT;
    int tid_ = threadIdx.x; asm volatile("" : "+v"(tid_)); const int tid = tid_, wid = __builtin_amdgcn_readfirstlane(tid >> 6), lane = tid & 63, wr = wid >> 2, wc = wid & 3, fr = lane & 15, fq = lane >> 4;
    const int K = X.K, nt = K / BK;
    int sR[2], sC[2]; unsigned voffB[2];
#pragma unroll
    for (int i = 0; i < 2; ++i) { int R, C; stage_rc(tid * 16 + i * 8192, R, C); const int Rb = Epi::PERM ? ((R & ~31) + perm32(R & 31)) : R; sR[i] = R; sC[i] = C; voffB[i] = (unsigned)(Rb * K + C) * 2u; }
    const size_t kstep = (size_t)(BK * 2);
    const size_t hstep = (size_t)HALF * K * 2;
    const unsigned ldsw = (unsigned)wid * 1024u;
    const int aoff = lds_byte(wr * 64 + fr, fq * 8), boff = lds_byte(wc * 32 + fr, fq * 8);
#define PG8_SA(b, h) (((b) * 2 + (h)) * HTB)
#define PG8_SB(b, h) ((4 + (b) * 2 + (h)) * HTB)
#define PG8_STAGE(bufoff, gbase, voff) do { _Pragma("unroll") for (int _i = 0; _i < 2; ++_i) \
        __builtin_amdgcn_global_load_lds((const unsigned*)((const char*)(gbase) + (voff)[_i]), (PG8_LAS unsigned*)(lds + (bufoff) + ldsw + _i * 8192), 16, 0, 0); } while (0)
#define PG8_LDA(dst, b, h) do { _Pragma("unroll") for (int m = 0; m < 4; ++m) _Pragma("unroll") for (int k = 0; k < 2; ++k) dst[m][k] = *(const PG8_LAS bf16x8*)(lds + PG8_SA(b, h) + aoff + m * 2048 + k * 1024); } while (0)
#define PG8_LDB(dst, b, h) do { _Pragma("unroll") for (int n = 0; n < 2; ++n) _Pragma("unroll") for (int k = 0; k < 2; ++k) dst[n][k] = *(const PG8_LAS bf16x8*)(lds + PG8_SB(b, h) + boff + n * 2048 + k * 1024); } while (0)
#define PG8_MMA(ai, bj, At, Bt) do { __builtin_amdgcn_s_setprio(1); _Pragma("unroll") for (int m = 0; m < 4; ++m) _Pragma("unroll") for (int n = 0; n < 2; ++n) _Pragma("unroll") for (int k = 0; k < 2; ++k) \
        acc[ai][bj][m][n] = __builtin_amdgcn_mfma_f32_16x16x32_bf16(Bt[n][k], At[m][k], acc[ai][bj][m][n], 0, 0, 0); __builtin_amdgcn_s_setprio(0); } while (0)
#define PG8_WAIT_V(n) asm volatile("s_waitcnt vmcnt(" #n ")" ::: "memory")
#define PG8_WAIT_L(n) asm volatile("s_waitcnt lgkmcnt(" #n ")" ::: "memory")
#define PG8_BAR __builtin_amdgcn_s_barrier()
#define PG8_SCHED __builtin_amdgcn_sched_barrier(0)
    UnitT cur, nxt; int ui = 0;
    if (!S.next(0, cur)) return;
    f32x4 acc[2][2][4][2];
#pragma unroll
    for (int a = 0; a < 2; ++a)
#pragma unroll
        for (int b = 0; b < 2; ++b)
#pragma unroll
            for (int m = 0; m < 4; ++m)
#pragma unroll
                for (int n = 0; n < 2; ++n) acc[a][b][m][n] = (f32x4){0.f, 0.f, 0.f, 0.f};
    bf16x8 At[4][2], B0[2][2], B1[2][2];
    unsigned oC0[2], oC1[2], oN0[2], oN1[2];
    { unsigned t2[2];
#pragma unroll
      for (int i = 0; i < 2; ++i) { X.a_offs(cur, sR[i], sC[i], t2); oC0[i] = t2[0]; oC1[i] = t2[1]; } }
    const char* const Ab = X.A;
    const char* cB = X.b_base(cur);
    PG8_STAGE(PG8_SB(0, 0), cB, voffB); PG8_STAGE(PG8_SB(0, 1), cB + hstep, voffB); PG8_STAGE(PG8_SA(0, 0), Ab, oC0); PG8_STAGE(PG8_SA(0, 1), Ab, oC1);
    if (wr == 1) PG8_BAR;
    PG8_WAIT_V(2); PG8_BAR;
    PG8_STAGE(PG8_SB(1, 0), cB + kstep, voffB); PG8_STAGE(PG8_SA(1, 0), Ab + kstep, oC0); PG8_STAGE(PG8_SB(1, 1), cB + hstep + kstep, voffB);
    PG8_WAIT_V(6); PG8_BAR;
    for (;;) {
        const bool has_next = S.next(ui + 1, nxt);
        const char* nB = cB;
#pragma unroll
        for (int i = 0; i < 2; ++i) { oN0[i] = oC0[i]; oN1[i] = oC1[i]; }
        if (has_next) { nB = X.b_base(nxt); unsigned t2[2];
#pragma unroll
            for (int i = 0; i < 2; ++i) { X.a_offs(nxt, sR[i], sC[i], t2); oN0[i] = t2[0]; oN1[i] = t2[1]; } }
        for (int t = 0; t < nt; t += 2) {
            const bool last = (t == nt - 2);
            const char* a1 = Ab + (size_t)(t + 1) * kstep;
            const char* a2 = last ? Ab : Ab + (size_t)(t + 2) * kstep; const char* b2 = last ? nB : cB + (size_t)(t + 2) * kstep;
            const char* a3 = a2 + kstep; const char* b3 = b2 + kstep;
            unsigned o20[2], o21[2];
#pragma unroll
            for (int i = 0; i < 2; ++i) { o20[i] = last ? oN0[i] : oC0[i]; o21[i] = last ? oN1[i] : oC1[i]; }
            PG8_LDB(B0, 0, 0); PG8_LDB(B1, 0, 1); PG8_SCHED; PG8_LDA(At, 0, 0); PG8_STAGE(PG8_SA(1, 1), a1, oC1);
            PG8_WAIT_V(8); PG8_WAIT_L(0); PG8_BAR; PG8_MMA(0, 0, At, B0); PG8_MMA(0, 1, At, B1); PG8_BAR; PG8_SCHED;
            PG8_LDA(At, 0, 1); PG8_STAGE(PG8_SB(0, 0), b2, voffB); PG8_STAGE(PG8_SB(0, 1), b2 + hstep, voffB); PG8_STAGE(PG8_SA(0, 0), a2, o20);
            PG8_WAIT_V(8); PG8_WAIT_L(0); PG8_BAR; PG8_MMA(1, 0, At, B0); PG8_MMA(1, 1, At, B1); PG8_BAR; PG8_SCHED;
            PG8_LDB(B0, 1, 0); PG8_LDB(B1, 1, 1); PG8_SCHED; PG8_LDA(At, 1, 0); PG8_STAGE(PG8_SA(0, 1), a2, o21);
            PG8_WAIT_V(8); PG8_WAIT_L(0); PG8_BAR; PG8_MMA(0, 0, At, B0); PG8_MMA(0, 1, At, B1); PG8_BAR; PG8_SCHED;
            PG8_LDA(At, 1, 1); PG8_STAGE(PG8_SB(1, 0), b3, voffB); PG8_STAGE(PG8_SB(1, 1), b3 + hstep, voffB); PG8_STAGE(PG8_SA(1, 0), a3, o20);
            PG8_WAIT_V(8); PG8_WAIT_L(0); PG8_BAR; PG8_MMA(1, 0, At, B0); PG8_MMA(1, 1, At, B1); PG8_BAR; PG8_SCHED;
        }
        if (wr == 0) PG8_BAR;
        E(acc, cur, wr, wc, fr, fq);
        if (!has_next) break;
#pragma unroll
        for (int a = 0; a < 2; ++a)
#pragma unroll
            for (int b = 0; b < 2; ++b)
#pragma unroll
                for (int m = 0; m < 4; ++m)
#pragma unroll
                    for (int n = 0; n < 2; ++n) acc[a][b][m][n] = (f32x4){0.f, 0.f, 0.f, 0.f};
        cur = nxt; cB = nB; ++ui;
#pragma unroll
        for (int i = 0; i < 2; ++i) { oC0[i] = oN0[i]; oC1[i] = oN1[i]; }
        if (wr == 1) PG8_BAR;
    }
    PG8_WAIT_V(0);
    PG8_BAR;
#undef PG8_SA
#undef PG8_SB
#undef PG8_STAGE
#undef PG8_LDA
#undef PG8_LDB
#undef PG8_MMA
#undef PG8_WAIT_V
#undef PG8_WAIT_L
#undef PG8_BAR
#undef PG8_SCHED
}
}
#define GAS __attribute__((address_space(1)))
#define LAS __attribute__((address_space(3)))
typedef unsigned short bf16;
typedef unsigned v4u __attribute__((ext_vector_type(4)));
typedef float f32x4 __attribute__((ext_vector_type(4)));
typedef short bf16x8 __attribute__((ext_vector_type(8)));
typedef GAS unsigned gu32;
typedef GAS unsigned long long gu64;
#define RLX_AGENT __ATOMIC_RELAXED, __HIP_MEMORY_SCOPE_AGENT
#define LDS_WAIT() asm volatile("s_waitcnt lgkmcnt(0)" ::: "memory")
#define VM_WAIT() asm volatile("s_waitcnt vmcnt(0)" ::: "memory")
__device__ __forceinline__ unsigned long long rt() { return __builtin_amdgcn_s_memrealtime(); }
__device__ __forceinline__ unsigned f2bf(float f) { unsigned u = __builtin_bit_cast(unsigned, f); return (u + 0x7fffu + ((u >> 16) & 1u)) >> 16; }
__device__ __forceinline__ unsigned pk2(float lo, float hi) { return f2bf(lo) | (f2bf(hi) << 16); }

#define XB_TMO      128
#define XB_XCNT(j)  (256  + 64 * (j))
#define XB_XSUB(j)  (1280 + 64 * (j))
#define XB_XGEN(j)  (2304 + 64 * (j))
#define XB_TOP      3328
#define XB_TOPGEN   3392
#define XCD_BAR_WORDS 3456
#define XB_SPIN_CAP (1u << 18)

__device__ __forceinline__ unsigned xb_ld(unsigned* p)              { return __hip_atomic_load(p, __ATOMIC_RELAXED, __HIP_MEMORY_SCOPE_AGENT); }
__device__ __forceinline__ unsigned xb_add(unsigned* p, unsigned v) { return __hip_atomic_fetch_add(p, v, __ATOMIC_RELAXED, __HIP_MEMORY_SCOPE_AGENT); }
__device__ __forceinline__ unsigned xb_xcc_id() { return (unsigned)__builtin_amdgcn_s_getreg((3 << 11) | 20) & 0xFu; }
#define XB_SPIN(cond, bar) do { unsigned _sp = 0; while (cond) { __builtin_amdgcn_s_sleep(1); \
    if ((++_sp & 255u) == 0u) { if (xb_ld(&(bar)[XB_TMO])) break; if (_sp > XB_SPIN_CAP) { atomicAdd(&(bar)[XB_TMO], 1u); break; } } } } while (0)

struct XcdBarrier {
    unsigned* bar; unsigned x;
    volatile LAS unsigned* st;
};

__device__ __forceinline__ XcdBarrier xcd_barrier_post(unsigned* bar, volatile LAS unsigned* st) {
    XcdBarrier b; b.bar = bar; b.x = xb_xcc_id(); b.st = st;
    if (threadIdx.x == 0) (void)xb_add(&bar[XB_XCNT(b.x)], 1u);
    return b;
}
__device__ __forceinline__ void xcd_barrier_complete(unsigned* bar, unsigned x, unsigned& nloc, unsigned& nx) {
    const unsigned G = gridDim.x * gridDim.y * gridDim.z;
    unsigned sum, cnt, mine, sp = 0u;
    for (;;) {
        sum = 0u; cnt = 0u; mine = 0u;
#pragma unroll
        for (unsigned j = 0; j < 16; ++j) { const unsigned c = xb_ld(&bar[XB_XCNT(j)]); sum += c; cnt += (c > 0u) ? 1u : 0u; mine = (j == x) ? c : mine; }
        if (sum == G) break;
        __builtin_amdgcn_s_sleep(1);
        if ((++sp & 255u) == 0u) { if (xb_ld(&bar[XB_TMO])) break; if (sp > XB_SPIN_CAP) { atomicAdd(&bar[XB_TMO], 1u); break; } }
    }
    nloc = mine > 0u ? mine : 1u; nx = cnt > 0u ? cnt : 1u;
}

__device__ __forceinline__ void xcd_barrier(const XcdBarrier& b) {
    asm volatile("s_waitcnt vmcnt(0)" ::: "memory");
    __syncthreads();
    if (threadIdx.x == 0) {
        unsigned* bar = b.bar;
        __builtin_amdgcn_s_waitcnt(0);
        unsigned nloc = b.st[0], nx = b.st[1];
        if (nloc == 0u) { xcd_barrier_complete(bar, b.x, nloc, nx); b.st[0] = nloc; b.st[1] = nx; }
        const unsigned old = xb_add(&bar[XB_XSUB(b.x)], 1u);
        const unsigned gen = old / nloc;
        if (old + 1u == (gen + 1u) * nloc) {
            __builtin_amdgcn_fence(__ATOMIC_RELEASE, "agent");
            asm volatile("s_waitcnt vmcnt(0)" ::: "memory");
            const unsigned og = xb_add(&bar[XB_TOP], 1u);
            const unsigned tg = og / nx;
            if (og + 1u == (tg + 1u) * nx) xb_add(&bar[XB_TOPGEN], 1u);
            else XB_SPIN(xb_ld(&bar[XB_TOPGEN]) == tg, bar);
            __builtin_amdgcn_fence(__ATOMIC_ACQUIRE, "agent");
            xb_add(&bar[XB_XGEN(b.x)], 1u);
            asm volatile("s_waitcnt vmcnt(0)" ::: "memory");
        } else {
            XB_SPIN(xb_ld(&bar[XB_XGEN(b.x)]) == gen, bar);
            __builtin_amdgcn_fence(__ATOMIC_ACQUIRE, "agent");
            asm volatile("s_waitcnt vmcnt(0)" ::: "memory");
        }
    }
    __syncthreads();
}
namespace att {
typedef short bf16x8 __attribute__((ext_vector_type(8)));
typedef float f32x16 __attribute__((ext_vector_type(16)));
typedef float f32x4 __attribute__((ext_vector_type(4)));
typedef unsigned u32x4 __attribute__((ext_vector_type(4)));
typedef short v4i16_t __attribute__((ext_vector_type(4)));
typedef short s16x4 __attribute__((ext_vector_type(4)));
#define ATT_LAS __attribute__((address_space(3)))
constexpr int SLOTB = 8192;
constexpr int L_K = 0, L_V = 2 * SLOTB, L_WS = 4 * SLOTB, L_OST = L_WS + 8 * 256, L_CB = L_OST + 8 * 4096, L_BYTES = L_CB + 32768;
__device__ __forceinline__ int crow(int r, int hi) { return (r & 3) + 8 * (r >> 2) + 4 * hi; }
__device__ __forceinline__ unsigned cvtpk(float lo, float hi) { unsigned r; asm volatile("v_cvt_pk_bf16_f32 %0, %1, %2" : "=v"(r) : "v"(lo), "v"(hi)); return r; }

struct Unit {
    const unsigned short* Q; const unsigned short* K; const unsigned short* V;
    int qrow0, qstride, krow0, kstride;
    int nt0, nt1;
    int ioff, W;
    __attribute__((address_space(3))) const float* bias;
    unsigned short* O; int opitch;
    float* lse;
};

template <bool FOX>
__device__ __forceinline__ void attn_unit(const Unit& U, ATT_LAS unsigned char* lds) {
    int tid_ = threadIdx.x; asm volatile("" : "+v"(tid_)); const int tid = tid_, lane = tid & 63, r32 = lane & 31, hi = lane >> 5; const int wid = __builtin_amdgcn_readfirstlane(tid >> 6);
    bf16x8 qr[4];
    { const unsigned short* qp = U.Q + (size_t)(U.qrow0 + U.qstride * (32 * wid + r32)) * 512 + hi * 8;
#pragma unroll
      for (int d0 = 0; d0 < 4; ++d0) qr[d0] = *(const bf16x8*)(qp + d0 * 16); }
    const int lo_i = 32 * wid + U.ioff;
    const int wt0 = FOX ? U.nt0 : max(U.nt0, (lo_i - U.W) >> 6);
    const int wt1 = min(U.nt1, ((lo_i + 31) >> 6) + 1);
    float m = -INFINITY, l = 0.f; f32x16 o[2];
#pragma unroll
    for (int r = 0; r < 16; ++r) { o[0][r] = 0.f; o[1][r] = 0.f; }
    const int krow_k = lane, krow_v = 16 * (wid & 3) + (lane >> 2);
    const unsigned short* kbase = U.K + wid * 8;
    const unsigned short* vbase = U.V + (wid >> 2) * 32 + (lane & 3) * 8;
    ATT_LAS unsigned char* kdst = lds + L_K + wid * 1024 + lane * 16;
    ATT_LAS unsigned char* vdst = lds + L_V + wid * 1024 + lane * 16;
    ATT_LAS float* wsf = (ATT_LAS float*)(lds + L_WS) + wid * 64;
    u32x4 kreg, vreg;
#define ATT_LOAD(t) do { kreg = *(const u32x4*)(kbase + (size_t)(U.krow0 + U.kstride * (64 * (t) + krow_k)) * 512); \
                         vreg = *(const u32x4*)(vbase + (size_t)(U.krow0 + U.kstride * (64 * (t) + krow_v)) * 512); } while (0)
#define ATT_WRITE(slot) do { *(ATT_LAS u32x4*)(kdst + (slot) * SLOTB) = kreg; *(ATT_LAS u32x4*)(vdst + (slot) * SLOTB) = vreg; } while (0)
    ATT_LOAD(U.nt0); ATT_WRITE(0);
    __syncthreads();
    for (int t = U.nt0; t < U.nt1; ++t) {
        const int slot = (t - U.nt0) & 1; const bool more = (t + 1 < U.nt1);
        if (more) ATT_LOAD(t + 1);
        if (t >= wt0 && t < wt1) {
            ATT_LAS const unsigned char* Kb = lds + L_K + slot * SLOTB + hi * 1024 + r32 * 16;
            ATT_LAS const unsigned char* Vb = lds + L_V + slot * SLOTB + ((lane >> 4) & 1) * 32 + (lane & 3) * 8 + (4 * hi + ((lane & 15) >> 2)) * 64;
            f32x16 p0, p1;
            if (FOX) { ATT_LAS const float* Bb = U.bias + 64 * t + 4 * hi;
#pragma unroll
                for (int g = 0; g < 4; ++g) { const f32x4 b0 = *(ATT_LAS const f32x4*)(Bb + 8 * g), b1 = *(ATT_LAS const f32x4*)(Bb + 32 + 8 * g);
#pragma unroll
                    for (int i = 0; i < 4; ++i) { p0[4 * g + i] = b0[i]; p1[4 * g + i] = b1[i]; } }
            } else {
#pragma unroll
                for (int r = 0; r < 16; ++r) { p0[r] = 0.f; p1[r] = 0.f; }
            }
#pragma unroll
            for (int d0 = 0; d0 < 4; ++d0) {
                const bf16x8 a0 = *(ATT_LAS const bf16x8*)(Kb + d0 * 2048), a1 = *(ATT_LAS const bf16x8*)(Kb + d0 * 2048 + 512);
                p0 = __builtin_amdgcn_mfma_f32_32x32x16_bf16(a0, qr[d0], p0, 0, 0, 0);
                p1 = __builtin_amdgcn_mfma_f32_32x32x16_bf16(a1, qr[d0], p1, 0, 0, 0);
            }
            const bool full = (lo_i - (64 * t + 63) >= 0) && (FOX || (lo_i + 31 - 64 * t <= U.W));
            if (!full) {
                const int dl = lo_i + r32 - 64 * t - 4 * hi;
#pragma unroll
                for (int r = 0; r < 16; ++r) { const int d0v = dl - ((r & 3) + 8 * (r >> 2)), d1v = d0v - 32;
                    if (d0v < 0 || (!FOX && d0v > U.W)) p0[r] = -INFINITY;
                    if (d1v < 0 || (!FOX && d1v > U.W)) p1[r] = -INFINITY; }
            }
            float tm = fmaxf(p0[0], p1[0]);
#pragma unroll
            for (int r = 1; r < 16; ++r) tm = fmaxf(tm, fmaxf(p0[r], p1[r]));
            tm = fmaxf(tm, __shfl_xor(tm, 32));
            const float mn = fmaxf(m, tm);
            const float alpha = __builtin_amdgcn_exp2f(m - mn);
            m = mn;
            float ls = 0.f;
#pragma unroll
            for (int r = 0; r < 16; ++r) { p0[r] = __builtin_amdgcn_exp2f(p0[r] - mn); p1[r] = __builtin_amdgcn_exp2f(p1[r] - mn); ls += p0[r] + p1[r]; }
            l = l * alpha + ls;
            if (hi == 0) wsf[r32] = alpha;
            u32x4 pw[4];
#pragma unroll
            for (int i = 0; i < 4; ++i) { pw[0][i] = cvtpk(p0[2 * i], p0[2 * i + 1]); pw[1][i] = cvtpk(p0[8 + 2 * i], p0[9 + 2 * i]); pw[2][i] = cvtpk(p1[2 * i], p1[2 * i + 1]); pw[3][i] = cvtpk(p1[8 + 2 * i], p1[9 + 2 * i]); }
#pragma unroll
            for (int g = 0; g < 4; ++g) { const f32x4 a4 = *(ATT_LAS const f32x4*)(wsf + 8 * g + 4 * hi);
#pragma unroll
                for (int i = 0; i < 4; ++i) { o[0][4 * g + i] *= a4[i]; o[1][4 * g + i] *= a4[i]; } }
#pragma unroll
            for (int d0 = 0; d0 < 2; ++d0)
#pragma unroll
                for (int ks = 0; ks < 4; ++ks) {
                    const s16x4 vlo = __builtin_bit_cast(s16x4, __builtin_amdgcn_ds_read_tr16_b64_v4i16((ATT_LAS v4i16_t*)(Vb + d0 * 4096 + ks * 1024)));
                    const s16x4 vhi = __builtin_bit_cast(s16x4, __builtin_amdgcn_ds_read_tr16_b64_v4i16((ATT_LAS v4i16_t*)(Vb + d0 * 4096 + ks * 1024 + 512)));
                    const bf16x8 vf = (bf16x8){vlo[0], vlo[1], vlo[2], vlo[3], vhi[0], vhi[1], vhi[2], vhi[3]};
                    o[d0] = __builtin_amdgcn_mfma_f32_32x32x16_bf16(__builtin_bit_cast(bf16x8, pw[ks]), vf, o[d0], 0, 0, 0);
                }
        }
        if (more) ATT_WRITE(slot ^ 1);
        __syncthreads();
    }
#undef ATT_LOAD
#undef ATT_WRITE
    const float L = l + __shfl_xor(l, 32);
    if (hi == 0) wsf[r32] = L;
    if (!FOX) { if (hi == 0) U.lse[(size_t)(U.qrow0 + U.qstride * (32 * wid + r32)) * 8] = m + __builtin_amdgcn_logf(L); }
    float rli[16];
#pragma unroll
    for (int g = 0; g < 4; ++g) { const f32x4 a4 = *(ATT_LAS const f32x4*)(wsf + 8 * g + 4 * hi);
#pragma unroll
        for (int i = 0; i < 4; ++i) rli[4 * g + i] = __builtin_amdgcn_rcpf(a4[i]); }
    ATT_LAS unsigned short* stg = (ATT_LAS unsigned short*)(lds + L_OST) + wid * 2048;
#pragma unroll
    for (int r = 0; r < 16; ++r) { const int orow = crow(r, hi);
#pragma unroll
        for (int d0 = 0; d0 < 2; ++d0) stg[orow * 64 + d0 * 32 + r32] = (unsigned short)(cvtpk(o[d0][r] * rli[r], 0.f) & 0xffffu); }
#pragma unroll
    for (int i = 0; i < 4; ++i) { const int row = i * 8 + (lane >> 3), ch = lane & 7; const u32x4 v = *(ATT_LAS const u32x4*)(stg + row * 64 + ch * 8);
        *(u32x4*)(U.O + (size_t)(U.qrow0 + U.qstride * (32 * wid + row)) * U.opitch + ch * 8) = v; }
    __syncthreads();
}
#undef ATT_LAS
}
constexpr int NWAVES = 8;
constexpr int RING_OFF = 0, RING_BYTES = 131072;
constexpr int LDSCTL_OFF = 147456, MISC_OFF = LDSCTL_OFF + 320;
constexpr int LDS_BYTES = 163840;
constexpr int CW_TMO = 0, CW_CODE = 1;
constexpr int CW_BAR = 4096;
constexpr int CW_COUNT = 8192;
static_assert((CW_BAR + XCD_BAR_WORDS) * 4 <= (int)CTL_ZERO_BYTES && (CW_COUNT + 256) * 4 <= (int)CTL_ZERO_BYTES, "CTL words inside the memset region");

struct Frame {
    LAS unsigned char* lds;
    volatile LAS unsigned* MISC;
    gu32* ctl;
    int tid, lane, wave;
    int vcu, G;
};
__device__ __forceinline__ void frame_refresh(Frame& F) { int t = threadIdx.x; asm volatile("" : "+v"(t)); F.tid = t; F.lane = t & 63; F.wave = __builtin_amdgcn_readfirstlane(t >> 6); }
__device__ __forceinline__ float wave_sum(float v) {
#pragma unroll
    for (int o = 1; o < 64; o <<= 1) v += __shfl_xor(v, o);
    return v;
}
__device__ __forceinline__ float wave_max(float v) {
#pragma unroll
    for (int o = 1; o < 64; o <<= 1) v = fmaxf(v, __shfl_xor(v, o));
    return v;
}

struct MapIdent { int off; __device__ __forceinline__ int operator()(int n) const { return off + n; } };
struct MapWin { __device__ __forceinline__ int operator()(int c) const { const int tile = c >> 8, l = c & 255; return tile * 256 + 128 * ((l >> 5) & 1) + 32 * (l >> 6) + (l & 31); } };
struct MapGU { int base; __device__ __forceinline__ int operator()(int c) const { return base + (c >> 7) * 256 + (c & 127); } };
template <class RowMap>
__device__ __forceinline__ void p0_transpose_item(const float* W, int K, int ldw, int nblk, bf16* WT, const RowMap& rm, LAS float* scr, int item, int lane) {
    const int kb = item / nblk, nb = item % nblk, k0 = 64 * kb, n0 = 32 * nb;
#pragma unroll 8
    for (int i = 0; i < 32; ++i) { const int kk = 2 * i + (lane >> 5); scr[kk * 33 + (lane & 31)] = W[(size_t)(k0 + kk) * ldw + n0 + (lane & 31)]; }
    LDS_WAIT(); asm volatile("" ::: "memory");
    const int c = lane & 7;
#pragma unroll
    for (int j = 0; j < 4; ++j) { const int n = (lane >> 3) + 8 * j; const LAS float* s = scr + (8 * c) * 33 + n;
        v4u o; o.x = pk2(s[0 * 33], s[1 * 33]); o.y = pk2(s[2 * 33], s[3 * 33]); o.z = pk2(s[4 * 33], s[5 * 33]); o.w = pk2(s[6 * 33], s[7 * 33]);
        *(GAS v4u*)(WT + (size_t)rm(n0 + n) * K + k0 + 8 * c) = o; }
    LDS_WAIT(); asm volatile("" ::: "memory");
}

struct P0Args { const float* x; const float* norm_mix; const float* w_in; const float* b_forget; const float* w_out; const float* w_gate; const float* w_up; const float* w_down;
                bf16* Win_t; bf16* Wo_t; bf16* Wgu_t; bf16* Wd_t; bf16* XN; float* logf; float* cosT; float* sinT; const float* g0; const float* g1; const float* g2; const float* g3; float* gtab; };

__device__ __forceinline__ void p0_prologue(Frame& F, const P0Args& A) {
    frame_refresh(F);
    const int gw = F.vcu * NWAVES + F.wave, NGW = F.G * NWAVES;
    {
        LAS float* slab = (LAS float*)(F.lds + RING_OFF);
        for (int k = F.tid; k < 1024; k += NWAVES * 64) {
            const f32x4 a = *(const f32x4*)(A.w_in + (size_t)k * D_PROJ + 3072), b = *(const f32x4*)(A.w_in + (size_t)k * D_PROJ + 3076);
            const int j = k >> 8, ln = (k & 255) >> 2, i = k & 3; LAS float* d = slab + (size_t)(((j * 4 + i) * 64 + ln) * 8);
            *(LAS f32x4*)d = a; *(LAS f32x4*)(d + 4) = b;
        }
        __syncthreads();
        f32x4 g4[4];
#pragma unroll
        for (int j = 0; j < 4; ++j) g4[j] = *(const f32x4*)(A.norm_mix + 4 * F.lane + 256 * j);
        for (int m = gw; m < NT; m += NGW) {
            const GAS f32x4* xr = (const GAS f32x4*)(A.x + (size_t)m * D_MODEL) + F.lane;
            f32x4 v[4]; float ss = 0.f;
#pragma unroll
            for (int j = 0; j < 4; ++j) { v[j] = xr[64 * j]; ss += (v[j].x * v[j].x + v[j].y * v[j].y) + (v[j].z * v[j].z + v[j].w * v[j].w); }
            const float rs = 1.0f / sqrtf(wave_sum(ss) * (1.f / D_MODEL) + EPS);
            float fa[8];
#pragma unroll
            for (int c = 0; c < 8; ++c) fa[c] = 0.f;
            GAS unsigned long long* o8 = (GAS unsigned long long*)(A.XN + (size_t)m * D_MODEL) + F.lane;
#pragma unroll
            for (int j = 0; j < 4; ++j) {
                v[j] = v[j] * rs * g4[j];
                o8[64 * j] = (unsigned long long)pk2(v[j].x, v[j].y) | ((unsigned long long)pk2(v[j].z, v[j].w) << 32);
#pragma unroll
                for (int i = 0; i < 4; ++i) { const LAS float* d = slab + (size_t)(((j * 4 + i) * 64 + F.lane) * 8); const f32x4 w0 = *(const LAS f32x4*)d, w1 = *(const LAS f32x4*)(d + 4); const float xv = v[j][i];
                    fa[0] += xv * w0.x; fa[1] += xv * w0.y; fa[2] += xv * w0.z; fa[3] += xv * w0.w; fa[4] += xv * w1.x; fa[5] += xv * w1.y; fa[6] += xv * w1.z; fa[7] += xv * w1.w; }
            }
#pragma unroll
            for (int c = 0; c < 8; ++c) fa[c] = wave_sum(fa[c]);
            if (F.lane < 8) { float z = fa[0];
#pragma unroll
                for (int c = 1; c < 8; ++c) z = (F.lane == c) ? fa[c] : z;
                z += A.b_forget[F.lane];
                const float lf = fminf(z, 0.f) - log1pf(expf(-fabsf(z)));
                const int b = m / SEQ, t = m % SEQ; A.logf[(size_t)(b * NH + F.lane) * SEQ + t] = lf; }
        }
        __syncthreads();
    }
    if (blockIdx.x == 0 && F.tid < 64) { const int l = F.tid; A.gtab[l] = A.g0[l] * QSCALE; A.gtab[64 + l] = A.g1[l]; A.gtab[128 + l] = A.g2[l] * QSCALE; A.gtab[192 + l] = A.g3[l]; }
    for (int idx = (F.vcu * NWAVES * 64) + F.tid; idx < SEQ * 32; idx += F.G * NWAVES * 64) {
        const int pos = idx >> 5, i = idx & 31;
        const float inv_freq = 1.0f / exp2f(((float)(2 * i) / 64.0f) * 13.287712379549449f);
        const float ang = (float)pos * inv_freq;
        const double a = (double)ang; const double k = rint(a * 0.15915494309189535); const float rf = (float)(a - k * 6.283185307179586);
        A.cosT[idx] = cosf(rf); A.sinT[idx] = sinf(rf);
    }
    {
        LAS float* scr = (LAS float*)(F.lds + RING_OFF + F.wave * 16384);
        constexpr int I_IN = 16 * 96, I_O = 16 * 32, I_G = 16 * 16, I_D = 8 * 32;
        constexpr int NITEMS = I_IN + I_O + NE * (2 * I_G + I_D);
        for (int it = gw; it < NITEMS; it += NGW) {
            int r = it;
            if (r < I_IN) { p0_transpose_item(A.w_in, 1024, D_PROJ, 96, A.Win_t, MapWin{}, scr, r, F.lane); continue; } r -= I_IN;
            if (r < I_O) { p0_transpose_item(A.w_out, 1024, 1024, 32, A.Wo_t, MapIdent{0}, scr, r, F.lane); continue; } r -= I_O;
            const int e = r / (2 * I_G + I_D); r -= e * (2 * I_G + I_D);
            if (r < I_G) { p0_transpose_item(A.w_gate + (size_t)e * 1024 * 512, 1024, 512, 16, A.Wgu_t, MapGU{e * 1024}, scr, r, F.lane); continue; } r -= I_G;
            if (r < I_G) { p0_transpose_item(A.w_up + (size_t)e * 1024 * 512, 1024, 512, 16, A.Wgu_t, MapGU{e * 1024 + 128}, scr, r, F.lane); continue; } r -= I_G;
            p0_transpose_item(A.w_down + (size_t)e * 512 * 1024, 512, 1024, 32, A.Wd_t, MapIdent{e * 1024}, scr, r, F.lane);
        }
    }
}
constexpr size_t WS_DILP1 = WS_XN, WS_DILP2 = WS_XN + 16 * MiB;
struct P2Args { const bf16* qkv; const float* logf; bf16* A2; bf16* dilp1; bf16* dilp2; float* lse; };
__device__ __forceinline__ void p2_attention(Frame& F, const P2Args& A) {
    frame_refresh(F);
    const int bh = F.vcu >> 4, s = F.vcu & 15, b = bh >> 3, h = bh & 7;
    LAS unsigned char* lds = F.lds + RING_OFF;
    LAS float* cbL = (LAS float*)(lds + att::L_CB);
    {
        const float* lf = A.logf + (size_t)bh * SEQ + F.tid * 16;
        float v[16];
#pragma unroll
        for (int j = 0; j < 4; ++j) { const f32x4 x = *(const f32x4*)(lf + 4 * j); v[4 * j] = x.x; v[4 * j + 1] = x.y; v[4 * j + 2] = x.z; v[4 * j + 3] = x.w; }
        double loc = 0.0;
#pragma unroll
        for (int i = 0; i < 16; ++i) loc += (double)v[i];
        double inc = loc;
#pragma unroll
        for (int o = 1; o < 64; o <<= 1) { const double n = __shfl_up(inc, o); if (F.lane >= o) inc += n; }
        LAS double* wtot = (LAS double*)(lds + att::L_WS);
        if (F.lane == 63) wtot[F.wave] = inc;
        __syncthreads();
        double run = inc - loc;
        for (int w = 0; w < F.wave; ++w) run += wtot[w];
#pragma unroll
        for (int i = 0; i < 16; ++i) { run += (double)v[i]; cbL[F.tid * 16 + i] = (float)(-run * (double)LOG2E); }
        __syncthreads();
    }
    const unsigned short* QA = (const unsigned short*)A.qkv + h * 64;
    for (int k = 0; k < 2; ++k) {
        const int qb = (k == 0) ? s : 31 - s;
        att::Unit U;
        U.Q = QA; U.K = QA + QKV_TSTRIDE; U.V = QA + 2 * QKV_TSTRIDE;
        U.qrow0 = b * SEQ + 256 * qb; U.qstride = 1; U.krow0 = b * SEQ; U.kstride = 1; U.nt0 = 0; U.nt1 = 4 * qb + 4; U.ioff = 256 * qb; U.W = 1 << 30;
        U.bias = cbL; U.O = (unsigned short*)A.A2 + h * 64; U.opitch = 1024; U.lse = nullptr;
        att::attn_unit<true>(U, lds);
    }
    for (int k = 0; k < 6; ++k) {
        const int u = s * 6 + k, pat = u >> 5, blk = u & 31;
        const int dsh = 2 * pat, d = 1 << dsh, bpc = 32 >> dsh, r = blk / bpc, n = blk % bpc;
        att::Unit U;
        U.Q = QA + 3 * QKV_TSTRIDE; U.K = QA + 4 * QKV_TSTRIDE; U.V = QA + 5 * QKV_TSTRIDE;
        U.qrow0 = b * SEQ + r + d * 256 * n; U.qstride = d; U.krow0 = b * SEQ + r + d * (256 * n - 128); U.kstride = d; U.nt0 = (n == 0) ? 2 : 0; U.nt1 = 6; U.ioff = 128; U.W = 128;
        U.bias = cbL;
        if (pat == 0) { U.O = (unsigned short*)A.A2 + 512 + h * 64; U.opitch = 1024; } else { U.O = (unsigned short*)(pat == 1 ? A.dilp1 : A.dilp2) + h * 64; U.opitch = 512; }
        U.lse = A.lse + (size_t)pat * NT * 8 + h;
        att::attn_unit<false>(U, lds);
    }
}
__device__ __forceinline__ float bf_lo(unsigned w) { return __uint_as_float(w << 16); }
__device__ __forceinline__ float bf_hi(unsigned w) { return __uint_as_float(w & 0xffff0000u); }
struct P25Args { bf16* A2; const bf16* dilp1; const bf16* dilp2; const float* lse; const float* gf; const float* gd; };
__device__ __forceinline__ void p25_combine(Frame& F, const P25Args& A) {
    frame_refresh(F);
    const int gw = F.vcu * NWAVES + F.wave, NGW = F.G * NWAVES;
    float ga[8], gb[8];
#pragma unroll
    for (int j = 0; j < 2; ++j) { const f32x4 x = *(const f32x4*)(A.gf + 8 * F.lane + 4 * j), y = *(const f32x4*)(A.gd + 8 * F.lane + 4 * j);
        ga[4 * j] = x.x; ga[4 * j + 1] = x.y; ga[4 * j + 2] = x.z; ga[4 * j + 3] = x.w; gb[4 * j] = y.x; gb[4 * j + 1] = y.y; gb[4 * j + 2] = y.z; gb[4 * j + 3] = y.w; }
    const int head = F.lane >> 3;
    for (int m = gw; m < NT; m += NGW) {
        GAS v4u* rowA = (GAS v4u*)(A.A2 + (size_t)m * 1024) + F.lane;
        const v4u fa = rowA[0], d0 = rowA[64], d1 = *((const GAS v4u*)(A.dilp1 + (size_t)m * 512) + F.lane), d2 = *((const GAS v4u*)(A.dilp2 + (size_t)m * 512) + F.lane);
        const float l0 = A.lse[(size_t)m * 8 + head], l1 = A.lse[(size_t)(NT + m) * 8 + head], l2 = A.lse[(size_t)(2 * NT + m) * 8 + head];
        const float mx = fmaxf(l0, fmaxf(l1, l2));
        float w0 = __builtin_amdgcn_exp2f(l0 - mx), w1 = __builtin_amdgcn_exp2f(l1 - mx), w2 = __builtin_amdgcn_exp2f(l2 - mx);
        const float inv = 1.0f / (w0 + w1 + w2); w0 *= inv; w1 *= inv; w2 *= inv;
        float xa[8], xb[8]; float sa = 0.f, sb = 0.f;
#pragma unroll
        for (int j = 0; j < 4; ++j) {
            xa[2 * j] = bf_lo(fa[j]); xa[2 * j + 1] = bf_hi(fa[j]);
            xb[2 * j] = w0 * bf_lo(d0[j]) + w1 * bf_lo(d1[j]) + w2 * bf_lo(d2[j]); xb[2 * j + 1] = w0 * bf_hi(d0[j]) + w1 * bf_hi(d1[j]) + w2 * bf_hi(d2[j]);
            sa += xa[2 * j] * xa[2 * j] + xa[2 * j + 1] * xa[2 * j + 1]; sb += xb[2 * j] * xb[2 * j] + xb[2 * j + 1] * xb[2 * j + 1];
        }
        const float ra = 1.0f / sqrtf(wave_sum(sa) * (1.0f / 512.0f) + EPS), rb = 1.0f / sqrtf(wave_sum(sb) * (1.0f / 512.0f) + EPS);
        v4u oa, ob;
#pragma unroll
        for (int j = 0; j < 4; ++j) { oa[j] = pk2(xa[2 * j] * ra * ga[2 * j], xa[2 * j + 1] * ra * ga[2 * j + 1]); ob[j] = pk2(xb[2 * j] * rb * gb[2 * j], xb[2 * j + 1] * rb * gb[2 * j + 1]); }
        rowA[0] = oa; rowA[64] = ob;
    }
}
constexpr int CAP = 16384;
constexpr size_t WS_PAIRTOK = WS_WIN;
constexpr size_t WS_PAIRGATE = WS_WIN + 2 * MiB;
constexpr size_t WS_TOKPAIR = WS_ROUTE;
constexpr size_t WS_HN = WS_XN;
constexpr size_t WS_HMID = WS_QKV;
constexpr size_t WS_Y = WS_QKV + 40 * MiB;
static_assert(WS_Y + (size_t)40960 * 1024 * 2 <= WS_END, "ws map");
constexpr int MOE_CNT_OFF = MISC_OFF + 256, MOE_PT_OFF = MOE_CNT_OFF + 128, MOE_LCNT_OFF = MOE_PT_OFF + 256, MOE_LBASE_OFF = MOE_LCNT_OFF + 128, MOE_REC_OFF = MOE_LBASE_OFF + 128;
static_assert(MOE_REC_OFF + 64 * 32 <= LDS_BYTES, "LDS control region");

struct P35Args { const float* h; const float* gffn; const float* wrg; const float* brg; const float* wre; const float* bre; bf16* HN; int* pair_tok; float* pair_gate; int* tok_pair; gu32* gcount; };
__device__ __forceinline__ void p35_router(Frame& F, const P35Args& A) {
    frame_refresh(F);
    LAS float* WrgL = (LAS float*)(F.lds);
    LAS float* WreL = WrgL + 4096;
    LAS int* lcnt = (LAS int*)(F.lds + MOE_LCNT_OFF); LAS int* lbase = (LAS int*)(F.lds + MOE_LBASE_OFF); LAS unsigned* rec = (LAS unsigned*)(F.lds + MOE_REC_OFF);
    for (int k = F.tid; k < 1024; k += NWAVES * 64) {
        const int j = k >> 8, ln = (k & 255) >> 2, i = k & 3, slot = ((j * 4 + i) * 64 + ln) * 4;
        *(LAS f32x4*)(WrgL + slot) = *(const f32x4*)(A.wrg + (size_t)k * 4);
#pragma unroll
        for (int g = 0; g < 4; ++g) { const float* src = A.wre + ((size_t)g * 1024 + k) * 8;
            *(LAS f32x4*)(WreL + (g * 2 + 0) * 4096 + slot) = *(const f32x4*)src; *(LAS f32x4*)(WreL + (g * 2 + 1) * 4096 + slot) = *(const f32x4*)(src + 4); }
    }
    if (F.tid < 32) lcnt[F.tid] = 0;
    __syncthreads();
    f32x4 g4[4];
#pragma unroll
    for (int j = 0; j < 4; ++j) g4[j] = *(const f32x4*)(A.gffn + 4 * F.lane + 256 * j);
    const int tok0 = 64 * F.vcu + 8 * F.wave;
    for (int tt = 0; tt < 8; ++tt) {
        const int tok = tok0 + tt;
        const GAS f32x4* xr = (const GAS f32x4*)(A.h + (size_t)tok * D_MODEL) + F.lane;
        f32x4 v[4]; float ss = 0.f;
#pragma unroll
        for (int j = 0; j < 4; ++j) { v[j] = xr[64 * j]; ss += (v[j].x * v[j].x + v[j].y * v[j].y) + (v[j].z * v[j].z + v[j].w * v[j].w); }
        const float rs = 1.0f / sqrtf(wave_sum(ss) * (1.f / D_MODEL) + EPS);
        GAS unsigned long long* o8 = (GAS unsigned long long*)(A.HN + (size_t)tok * D_MODEL) + F.lane;
        f32x4 zg = (f32x4){0.f, 0.f, 0.f, 0.f};
#pragma unroll
        for (int j = 0; j < 4; ++j) {
            v[j] = v[j] * rs * g4[j];
            o8[64 * j] = (unsigned long long)pk2(v[j].x, v[j].y) | ((unsigned long long)pk2(v[j].z, v[j].w) << 32);
#pragma unroll
            for (int i = 0; i < 4; ++i) zg += v[j][i] * *(const LAS f32x4*)(WrgL + ((j * 4 + i) * 64 + F.lane) * 4);
        }
        float z[4];
#pragma unroll
        for (int g = 0; g < 4; ++g) z[g] = wave_sum(zg[g]) + A.brg[g];
        int gs = 0; float zm = z[0];
#pragma unroll
        for (int g = 1; g < 4; ++g) if (z[g] > zm) { zm = z[g]; gs = g; }
        float den = 0.f;
#pragma unroll
        for (int g = 0; g < 4; ++g) den += expf(z[g] - zm);
        const float pg_top = 1.0f / den;
        gs = __builtin_amdgcn_readfirstlane(gs);
        const LAS float* W0 = WreL + (gs * 2) * 4096; const LAS float* W1 = W0 + 4096;
        f32x4 ea = (f32x4){0.f, 0.f, 0.f, 0.f}, eb = ea;
#pragma unroll
        for (int j = 0; j < 4; ++j)
#pragma unroll
            for (int i = 0; i < 4; ++i) { const int slot = ((j * 4 + i) * 64 + F.lane) * 4; ea += v[j][i] * *(const LAS f32x4*)(W0 + slot); eb += v[j][i] * *(const LAS f32x4*)(W1 + slot); }
        float ze[8];
#pragma unroll
        for (int e = 0; e < 4; ++e) { ze[e] = wave_sum(ea[e]) + A.bre[gs * 8 + e]; ze[4 + e] = wave_sum(eb[e]) + A.bre[gs * 8 + 4 + e]; }
        int i1 = 0; float v1 = ze[0];
#pragma unroll
        for (int e = 1; e < 8; ++e) if (ze[e] > v1) { v1 = ze[e]; i1 = e; }
        int i2 = 0; float v2 = -INFINITY;
#pragma unroll
        for (int e = 0; e < 8; ++e) if (e != i1 && ze[e] > v2) { v2 = ze[e]; i2 = e; }
        const float e2 = expf(v2 - v1); const float g1 = pg_top / (1.0f + e2), g2 = pg_top * e2 / (1.0f + e2);
        if (F.lane == 0) {
            const int ea1 = gs * 8 + i1, ea2 = gs * 8 + i2;
            const int r1 = __hip_atomic_fetch_add(lcnt + ea1, 1, __ATOMIC_RELAXED, __HIP_MEMORY_SCOPE_WORKGROUP), r2 = __hip_atomic_fetch_add(lcnt + ea2, 1, __ATOMIC_RELAXED, __HIP_MEMORY_SCOPE_WORKGROUP);
            LAS unsigned* rc = rec + (8 * F.wave + tt) * 8;
            rc[0] = (unsigned)ea1; rc[1] = (unsigned)ea2; rc[2] = __float_as_uint(g1); rc[3] = __float_as_uint(g2); rc[4] = (unsigned)r1; rc[5] = (unsigned)r2;
        }
    }
    __syncthreads();
    if (F.tid < 32) { const int c = lcnt[F.tid]; lbase[F.tid] = c ? (int)__hip_atomic_fetch_add(A.gcount + F.tid, (unsigned)c, RLX_AGENT) : 0; }
    __syncthreads();
    if (F.tid < 64) {
        const LAS unsigned* rc = rec + F.tid * 8; const int tok = 64 * F.vcu + F.tid;
#pragma unroll
        for (int s = 0; s < 2; ++s) { const int e = (int)rc[s], idx = lbase[e] + (int)rc[4 + s];
            A.pair_tok[e * CAP + idx] = tok; A.pair_gate[e * CAP + idx] = __uint_as_float(rc[2 + s]); A.tok_pair[tok * 2 + s] = (e << 16) | idx; }
    }
}
__device__ __forceinline__ void moe_tables(Frame& F, gu32* gcount) {
    frame_refresh(F);
    LAS int* cnt = (LAS int*)(F.lds + MOE_CNT_OFF); LAS int* pt = (LAS int*)(F.lds + MOE_PT_OFF);
    if (F.tid < 64) {
        const int c = (F.lane < 32) ? (int)__hip_atomic_load(gcount + F.lane, RLX_AGENT) : 0;
        const int tl = (c + 255) >> 8; int inc = tl;
#pragma unroll
        for (int o = 1; o < 32; o <<= 1) { const int n = __shfl_up(inc, o); if (F.lane >= o) inc += n; }
        if (F.lane < 32) { cnt[F.lane] = c; pt[F.lane] = inc - tl; }
        if (F.lane == 31) pt[32] = inc;
    }
    __syncthreads();
}
namespace pg8 {
struct MoeUnit { int e, mt, pn, rows, crow0; };
struct MoeSched {
    typedef MoeUnit UnitT;
    const PG8_LAS int* cnt; const PG8_LAS int* pt; int G, c, nunits;
    __device__ __forceinline__ void init(const PG8_LAS int* cnt_, const PG8_LAS int* pt_, int G_, int c_) { cnt = cnt_; pt = pt_; G = G_; c = c_; nunits = pt_[32] * 4; }
    __device__ __forceinline__ bool next(int i, MoeUnit& u) const {
        const int L = i * G + c; if (L >= nunits) return false;
        int wgid = L; { const int q = nunits / NXCD, r = nunits % NXCD, xcd = wgid % NXCD, off = wgid / NXCD; wgid = (xcd < r ? xcd * (q + 1) : r * (q + 1) + (xcd - r) * q) + off; }
        const int mtg = wgid >> 2; u.pn = wgid & 3;
        int e = 0;
        for (int k = 16; k >= 1; k >>= 1) if (e + k < 32 && pt[e + k] <= mtg) e += k;
        while (e < 31 && pt[e + 1] <= mtg) ++e;
        u.e = e; u.mt = mtg - pt[e]; u.rows = min(256, cnt[e] - 256 * u.mt); u.crow0 = 256 * mtg;
        return true;
    }
};
struct SrcGU {
    const char* A; int K; const int* pair_tok; const char* Bt;
    __device__ __forceinline__ void a_offs(const MoeUnit& u, int R, int C, unsigned (&off)[2]) const {
#pragma unroll
        for (int h = 0; h < 2; ++h) { const int r = h * 128 + R; const int tok = (r < u.rows) ? pair_tok[u.e * CAP + 256 * u.mt + r] : 0; off[h] = (unsigned)(tok * K + C) * 2u; }
    }
    __device__ __forceinline__ const char* b_base(const MoeUnit& u) const { return Bt + ((size_t)u.e * 1024 + 256 * u.pn) * (size_t)K * 2; }
};
struct SrcDown {
    const char* A; int K; const char* Bt;
    __device__ __forceinline__ void a_offs(const MoeUnit& u, int R, int C, unsigned (&off)[2]) const {
#pragma unroll
        for (int h = 0; h < 2; ++h) off[h] = (unsigned)((u.crow0 + h * 128 + R) * K + C) * 2u;
    }
    __device__ __forceinline__ const char* b_base(const MoeUnit& u) const { return Bt + ((size_t)u.e * 1024 + 256 * u.pn) * (size_t)K * 2; }
};
struct EpiGU {
    static constexpr bool PERM = true;
    bf16_t* H;
    __device__ __forceinline__ void operator()(const f32x4 (&acc)[2][2][4][2], const MoeUnit& u, int wr, int wc, int fr_, int fq) const {
        int fr = fr_; asm volatile("" : "+v"(fr));
        const unsigned col0 = (unsigned)(u.pn * 128 + wc * 32 + 8 * fq);
#pragma unroll
        for (int ai = 0; ai < 2; ++ai)
#pragma unroll
            for (int m = 0; m < 4; ++m) { const unsigned r = (unsigned)(u.crow0 + ai * HALF + wr * 64 + m * 16 + fr); float hv[8];
#pragma unroll
                for (int n = 0; n < 2; ++n)
#pragma unroll
                    for (int i = 0; i < 4; ++i) { const float gt = acc[ai][0][m][n][i], up = acc[ai][1][m][n][i];
                        hv[4 * n + i] = gt * __builtin_amdgcn_rcpf(1.0f + __builtin_amdgcn_exp2f(-gt * LOG2E)) * up; }
                u32x4 w; w.x = cvt_pk_bf16(hv[0], hv[1]); w.y = cvt_pk_bf16(hv[2], hv[3]); w.z = cvt_pk_bf16(hv[4], hv[5]); w.w = cvt_pk_bf16(hv[6], hv[7]);
                *(u32x4*)(H + (r * (unsigned)D_EXP + col0)) = w; }
    }
};
struct EpiDown {
    static constexpr bool PERM = true;
    bf16_t* Y; const float* pair_gate;
    __device__ __forceinline__ void operator()(const f32x4 (&acc)[2][2][4][2], const MoeUnit& u, int wr, int wc, int fr_, int fq) const {
        int fr = fr_; asm volatile("" : "+v"(fr));
        const unsigned col0 = (unsigned)(u.pn * BM + wc * 32 + 8 * fq);
        const float* gp = pair_gate + (u.e * CAP + 256 * u.mt);
#pragma unroll
        for (int ai = 0; ai < 2; ++ai)
#pragma unroll
            for (int m = 0; m < 4; ++m) { const int rl = ai * HALF + wr * 64 + m * 16 + fr; const unsigned off = (unsigned)(u.crow0 + rl) * (unsigned)D_MODEL + col0;
                const float gt = (rl < u.rows) ? gp[rl] : 0.f;
#pragma unroll
                for (int bj = 0; bj < 2; ++bj) { const f32x4 v0 = acc[ai][bj][m][0] * gt, v1 = acc[ai][bj][m][1] * gt;
                    u32x4 w; w.x = cvt_pk_bf16(v0[0], v0[1]); w.y = cvt_pk_bf16(v0[2], v0[3]); w.z = cvt_pk_bf16(v1[0], v1[1]); w.w = cvt_pk_bf16(v1[2], v1[3]);
                    *(u32x4*)(Y + (off + (unsigned)(bj * HALF))) = w; } }
    }
};
}
struct P6Args { float* out; const bf16* Y; const int* tok_pair; };
__device__ __forceinline__ void p6_final(Frame& F, const P6Args& A) {
    frame_refresh(F);
    const LAS int* pt = (const LAS int*)(F.lds + MOE_PT_OFF);
    const int gw = F.vcu * NWAVES + F.wave, NGW = F.G * NWAVES;
    for (int m = gw; m < NT; m += NGW) {
        const int p1 = A.tok_pair[m * 2], p2 = A.tok_pair[m * 2 + 1];
        const size_t r1 = (size_t)(256 * pt[p1 >> 16] + (p1 & 0xffff)), r2 = (size_t)(256 * pt[p2 >> 16] + (p2 & 0xffff));
        GAS f32x4* orow = (GAS f32x4*)(A.out + (size_t)m * D_MODEL) + F.lane;
        const GAS unsigned long long* y1 = (const GAS unsigned long long*)(A.Y + r1 * D_MODEL) + F.lane; const GAS unsigned long long* y2 = (const GAS unsigned long long*)(A.Y + r2 * D_MODEL) + F.lane;
#pragma unroll
        for (int j = 0; j < 4; ++j) { f32x4 o = orow[64 * j]; const unsigned long long a = y1[64 * j], b = y2[64 * j];
            const unsigned a0 = (unsigned)a, a1 = (unsigned)(a >> 32), b0 = (unsigned)b, b1 = (unsigned)(b >> 32);
            o.x += bf_lo(a0) + bf_lo(b0); o.y += bf_hi(a0) + bf_hi(b0); o.z += bf_lo(a1) + bf_lo(b1); o.w += bf_hi(a1) + bf_hi(b1);
            orow[64 * j] = o; }
    }
}
struct Args { const float* in[19]; float* out; unsigned char* ws; };
__global__ void __launch_bounds__(NWAVES * 64, 2) mk_fwd(Args args) {
    extern __shared__ __attribute__((aligned(16))) unsigned char lds[];
    Frame F;
    F.lds = (LAS unsigned char*)lds;
    F.MISC = (volatile LAS unsigned*)(F.lds + MISC_OFF);
    F.tid = threadIdx.x; F.lane = F.tid & 63; F.wave = __builtin_amdgcn_readfirstlane(F.tid >> 6);
    F.G = gridDim.x; { const int bx = blockIdx.x; F.vcu = (F.G % 8 == 0) ? (bx % 8) * (F.G / 8) + bx / 8 : bx; }
    unsigned char* ws = args.ws;
    F.ctl = (gu32*)(ws + WS_CTL);
    for (int u = F.tid; u < (LDS_BYTES - LDSCTL_OFF) / 4; u += NWAVES * 64) ((LAS unsigned*)(F.lds + LDSCTL_OFF))[u] = 0u;
    __syncthreads();
    XcdBarrier bar = xcd_barrier_post((unsigned*)(F.ctl + CW_BAR), F.MISC + 8);

    {
        P0Args A{args.in[0], args.in[1], args.in[2], args.in[3], args.in[10], args.in[16], args.in[17], args.in[18],
                 (bf16*)(ws + WS_WIN), (bf16*)(ws + WS_WO), (bf16*)(ws + WS_WGU), (bf16*)(ws + WS_WD), (bf16*)(ws + WS_XN), (float*)(ws + WS_LOGF), (float*)(ws + WS_ROPE), (float*)(ws + WS_ROPE) + SEQ * 32,
                 args.in[4], args.in[5], args.in[6], args.in[7], (float*)(ws + WS_GTAB)};
        p0_prologue(F, A);
    }
    xcd_barrier(bar);
    {
        pg8::Gemm g{(const pg8::bf16_t*)(ws + WS_XN), (const pg8::bf16_t*)(ws + WS_WIN), NT, NQKV, D_MODEL};
        pg8::StaticOrder S; S.init(NT, NQKV, F.G, (int)blockIdx.x);
        pg8::EpiQKV E{(pg8::bf16_t*)(ws + WS_QKV), (const float*)(ws + WS_GTAB), (const float*)(ws + WS_ROPE), (const float*)(ws + WS_ROPE) + SEQ * 32};
        pg8::gemm_phase<pg8::EpiQKV, pg8::StaticOrder, true, true>(F.lds + RING_OFF, g, S, E);
    }
    xcd_barrier(bar);
    {
        P2Args A{(const bf16*)(ws + WS_QKV), (const float*)(ws + WS_LOGF), (bf16*)(ws + WS_A2), (bf16*)(ws + WS_DILP1), (bf16*)(ws + WS_DILP2), (float*)(ws + WS_LSE)};
        p2_attention(F, A);
    }
    xcd_barrier(bar);
    {
        P25Args A{(bf16*)(ws + WS_A2), (const bf16*)(ws + WS_DILP1), (const bf16*)(ws + WS_DILP2), (const float*)(ws + WS_LSE), args.in[8], args.in[9]};
        p25_combine(F, A);
    }
    xcd_barrier(bar);
    {
        pg8::Gemm g{(const pg8::bf16_t*)(ws + WS_A2), (const pg8::bf16_t*)(ws + WS_WO), NT, D_MODEL, D_MODEL};
        pg8::StaticOrder S; S.init(NT, D_MODEL, F.G, (int)blockIdx.x);
        pg8::EpiRes E{args.in[0], args.out};
        pg8::gemm_phase<pg8::EpiRes, pg8::StaticOrder, true, true>(F.lds + RING_OFF, g, S, E);
    }
    xcd_barrier(bar);
    {
        P35Args A{args.out, args.in[11], args.in[12], args.in[13], args.in[14], args.in[15], (bf16*)(ws + WS_HN), (int*)(ws + WS_PAIRTOK), (float*)(ws + WS_PAIRGATE), (int*)(ws + WS_TOKPAIR), F.ctl + CW_COUNT};
        p35_router(F, A);
    }
    xcd_barrier(bar);
    moe_tables(F, F.ctl + CW_COUNT);
    {
        pg8::MoeSched S; S.init((const LAS int*)(F.lds + MOE_CNT_OFF), (const LAS int*)(F.lds + MOE_PT_OFF), F.G, (int)blockIdx.x);
        pg8::SrcGU X{(const char*)(ws + WS_HN), D_MODEL, (const int*)(ws + WS_PAIRTOK), (const char*)(ws + WS_WGU)};
        pg8::EpiGU E{(pg8::bf16_t*)(ws + WS_HMID)};
        pg8::gemm_phase2<pg8::EpiGU, pg8::MoeSched, pg8::SrcGU>(F.lds + RING_OFF, S, X, E);
    }
    xcd_barrier(bar);
    {
        pg8::MoeSched S; S.init((const LAS int*)(F.lds + MOE_CNT_OFF), (const LAS int*)(F.lds + MOE_PT_OFF), F.G, (int)blockIdx.x);
        pg8::SrcDown X{(const char*)(ws + WS_HMID), D_EXP, (const char*)(ws + WS_WD)};
        pg8::EpiDown E{(pg8::bf16_t*)(ws + WS_Y), (const float*)(ws + WS_PAIRGATE)};
        pg8::gemm_phase2<pg8::EpiDown, pg8::MoeSched, pg8::SrcDown>(F.lds + RING_OFF, S, X, E);
    }
    xcd_barrier(bar);
    {
        P6Args A{args.out, (const bf16*)(ws + WS_Y), (const int*)(ws + WS_TOKPAIR)};
        p6_final(F, A);
    }
}
extern "C" void kernel_launch(void* const* d_in, const int* in_sizes, int n_in, void* d_out, int out_size, void* d_ws, size_t ws_size, hipStream_t stream) {
    static int grid = 0;
    if (grid == 0) {
        if (n_in != 19 || ws_size < WS_END) { fprintf(stderr, "kernel_launch: bad arguments (n_in %d, ws %zu)\n", n_in, ws_size); grid = -1; return; }
        int dev = 0, cus = 0;
        if (hipGetDevice(&dev) != hipSuccess || hipDeviceGetAttribute(&cus, hipDeviceAttributeMultiprocessorCount, dev) != hipSuccess) { grid = -1; return; }
        if (hipFuncSetAttribute((const void*)mk_fwd, hipFuncAttributeMaxDynamicSharedMemorySize, LDS_BYTES) != hipSuccess) { fprintf(stderr, "kernel_launch: hipFuncSetAttribute failed\n"); grid = -1; return; }
        int per_cu = 0;
        if (hipOccupancyMaxActiveBlocksPerMultiprocessor(&per_cu, (const void*)mk_fwd, NWAVES * 64, LDS_BYTES) != hipSuccess || per_cu < 1) fprintf(stderr, "kernel_launch: occupancy query says %d\n", per_cu);
        (void)hipGetLastError();
        grid = cus;
        if (grid != 256) { fprintf(stderr, "kernel_launch: this build needs 256 CUs (got %d)\n", cus); grid = -1; return; }
    }
    if (grid < 0) return;
    char* ws = (char*)d_ws; float* out = (float*)d_out;
    (void)hipMemsetAsync(ws + WS_CTL, 0, CTL_ZERO_BYTES, stream);
    Args a{};
    for (int i = 0; i < 19; ++i) a.in[i] = (const float*)d_in[i];
    a.out = out; a.ws = (unsigned char*)d_ws;
    hipLaunchKernelGGL(mk_fwd, dim3(grid), dim3(NWAVES * 64), LDS_BYTES, stream, a);
}
```

```cpp
#ifndef REP
#define REP 0
#endif
#include <hip/hip_runtime.h>
#include <stdint.h>
#include <math.h>
#include <cstdio>

constexpr int D_MODEL = 1024, BATCH = 2, SEQ = 8192, NT = BATCH * SEQ;
constexpr int HD = 64, NH = 8, D_PROJ = 3080, NQKV = 3072;
constexpr int NE = 32, D_EXP = 512;
constexpr float EPS = 1e-6f;
constexpr float LOG2E = 1.4426950408889634f;
constexpr float QSCALE = 0.125f * LOG2E;

constexpr size_t MiB = 1u << 20, KiB = 1024;
constexpr size_t WS_CTL = 0, CTL_ZERO_BYTES = 128 * KiB;
constexpr size_t WS_GTAB = 256 * KiB;
constexpr size_t WS_LOGF = 512 * KiB;
constexpr size_t WS_ROPE = 1 * MiB;
constexpr size_t WS_CB = 3 * MiB;
constexpr size_t WS_ROUTE = 3 * MiB + 512 * KiB;
constexpr size_t WS_LSE = 4 * MiB + 512 * KiB;
constexpr size_t WS_WIN = 6 * MiB;
constexpr size_t WS_WO = 12 * MiB;
constexpr size_t WS_WGU = 14 * MiB;
constexpr size_t WS_WD = 78 * MiB;
constexpr size_t WS_XN = 110 * MiB;
constexpr size_t WS_QKV = 142 * MiB;
constexpr size_t QKV_TSTRIDE = (size_t)NT * 512;
constexpr size_t WS_A2 = 238 * MiB;
constexpr size_t WS_END = 270 * MiB;
namespace pg8 {
#define PG8_LAS __attribute__((address_space(3)))
typedef unsigned short bf16_t;
typedef short bf16x8 __attribute__((ext_vector_type(8)));
typedef float f32x4 __attribute__((ext_vector_type(4)));
typedef unsigned u32x4 __attribute__((ext_vector_type(4)));
constexpr int BM = 256, BK = 64, HALF = 128, HTB = HALF * BK * 2  , STAGE_BYTES = 8 * HTB, NXCD = 8, WGM = 8;

__host__ __device__ __forceinline__ int lds_byte(int r, int c) { const int st = (r >> 4) * 2 + (c >> 5), rr = r & 15, cc = c & 31, ob = rr * 64 + cc * 2; return st * 1024 + (ob ^ (((ob >> 9) & 1) << 5)); }
__host__ __device__ __forceinline__ void stage_rc(int b, int& R, int& C) { const int st = b / 1024, sb = b % 1024, swz = sb ^ (((sb >> 9) & 1) << 5); R = (st >> 1) * 16 + swz / 64; C = (st & 1) * 32 + (swz % 64) / 2; }
__host__ __device__ __forceinline__ int perm32(int rho) { const int n = rho >> 4, i = rho & 15; return 8 * (i >> 2) + 4 * n + (i & 3); }

struct Unit { int pm, pn; };
struct Gemm { const bf16_t* A; const bf16_t* Bt; int M, N, K; };

struct StaticOrder {
    int nM, nN, nwg, G, c;
    __host__ __device__ void init(int M, int N, int G_, int c_) { nM = M / BM; nN = N / BM; nwg = nM * nN; G = G_; c = c_; }
    __host__ __device__ bool next(int i, Unit& u) const {
        const long L = (long)i * G + c; if (L >= nwg) return false;
        int wgid = (int)L; { const int q = nwg / NXCD, r = nwg % NXCD, xcd = wgid % NXCD, off = wgid / NXCD; wgid = (xcd < r ? xcd * (q + 1) : r * (q + 1) + (xcd - r) * q) + off; }
        const int nig = WGM * nN, gid = wgid / nig, fm = gid * WGM, gsz = (nM - fm) < WGM ? (nM - fm) : WGM;
        u.pm = fm + ((wgid % nig) % gsz); u.pn = (wgid % nig) / gsz; return true;
    }
    __device__ __forceinline__ void a_ready(const Unit&) const {}
    __device__ __forceinline__ void done(const Unit&) const {}
};

__device__ __forceinline__ unsigned cvt_pk_bf16(float lo, float hi) { unsigned r; asm volatile("v_cvt_pk_bf16_f32 %0, %1, %2" : "=v"(r) : "v"(lo), "v"(hi)); return r; }

struct EpiQKV {
    static constexpr bool PERM = true, AFTER_DRAIN = false;
    bf16_t* qkv; const float* gtab; const float* cosT; const float* sinT;
    __device__ __forceinline__ void operator()(const f32x4 (&acc)[2][2][4][2], const Unit& u, int wr, int wc, int fr, int fq) const {
        const int tt = u.pn >> 1, head = (u.pn & 1) * 4 + wc;
        bf16_t* T = qkv + (size_t)tt * QKV_TSTRIDE + head * 64 + 8 * fq;
        const bool nrm = (tt != 2 && tt != 5), rope = (tt == 3 || tt == 4);
        f32x4 gv[2][2];
#pragma unroll
        for (int bj = 0; bj < 2; ++bj)
#pragma unroll
            for (int n = 0; n < 2; ++n) gv[bj][n] = (f32x4){1.f, 1.f, 1.f, 1.f};
        if (nrm) { const int gi = (tt == 0) ? 0 : (tt == 1) ? 1 : (tt == 3) ? 2 : 3; const float* g = gtab + gi * 64;
#pragma unroll
            for (int bj = 0; bj < 2; ++bj)
#pragma unroll
                for (int n = 0; n < 2; ++n) gv[bj][n] = *(const f32x4*)(g + 32 * bj + 8 * fq + 4 * n); }
#pragma unroll
        for (int ai = 0; ai < 2; ++ai)
#pragma unroll
            for (int m = 0; m < 4; ++m) {
                const int row = u.pm * BM + ai * HALF + wr * 64 + m * 16 + fr;
                f32x4 v[2][2];
#pragma unroll
                for (int bj = 0; bj < 2; ++bj)
#pragma unroll
                    for (int n = 0; n < 2; ++n) v[bj][n] = acc[ai][bj][m][n];
                if (nrm) {
                    float ss = 0.f;
#pragma unroll
                    for (int bj = 0; bj < 2; ++bj)
#pragma unroll
                        for (int n = 0; n < 2; ++n) { const f32x4 x = v[bj][n]; ss += (x[0] * x[0] + x[1] * x[1]) + (x[2] * x[2] + x[3] * x[3]); }
                    ss += __shfl_xor(ss, 16); ss += __shfl_xor(ss, 32);
                    const float rs = __builtin_amdgcn_rsqf(ss * (1.0f / 64.0f) + EPS);
#pragma unroll
                    for (int bj = 0; bj < 2; ++bj)
#pragma unroll
                        for (int n = 0; n < 2; ++n) v[bj][n] = v[bj][n] * rs * gv[bj][n];
                }
                if (rope) {
                    const int pos = row & (SEQ - 1);
#pragma unroll
                    for (int n = 0; n < 2; ++n) {
                        const f32x4 c = *(const f32x4*)(cosT + pos * 32 + 8 * fq + 4 * n), s = *(const f32x4*)(sinT + pos * 32 + 8 * fq + 4 * n);
                        const f32x4 x1 = v[0][n], x2 = v[1][n];
                        v[0][n] = x1 * c - x2 * s; v[1][n] = x2 * c + x1 * s;
                    }
                }
#pragma unroll
                for (int bj = 0; bj < 2; ++bj) { u32x4 w; w.x = cvt_pk_bf16(v[bj][0][0], v[bj][0][1]); w.y = cvt_pk_bf16(v[bj][0][2], v[bj][0][3]); w.z = cvt_pk_bf16(v[bj][1][0], v[bj][1][1]); w.w = cvt_pk_bf16(v[bj][1][2], v[bj][1][3]);
                    *(u32x4*)(T + (size_t)row * 512 + 32 * bj) = w; }
            }
    }
};
struct EpiRes {
    static constexpr bool PERM = false, AFTER_DRAIN = false;
    const float* X; float* out;
    __device__ __forceinline__ void operator()(const f32x4 (&acc)[2][2][4][2], const Unit& u, int wr, int wc, int fr, int fq) const {
        const int col0 = u.pn * BM + wc * 32 + 4 * fq;
#pragma unroll
        for (int ai = 0; ai < 2; ++ai)
#pragma unroll
            for (int m = 0; m < 4; ++m) { const size_t off = (size_t)(u.pm * BM + ai * HALF + wr * 64 + m * 16 + fr) * D_MODEL + col0;
#pragma unroll
                for (int bj = 0; bj < 2; ++bj)
#pragma unroll
                    for (int n = 0; n < 2; ++n) { const f32x4 xv = *(const f32x4*)(X + off + bj * HALF + n * 16); *(f32x4*)(out + off + bj * HALF + n * 16) = xv + acc[ai][bj][m][n]; } }
    }
};
template <class Epi, class Sched, bool ALIGN_EPI = false, bool SP2 = false>
__device__ __forceinline__ void gemm_phase(PG8_LAS unsigned char* lds, const Gemm g, const Sched& S, const Epi& E) {
    int tid_ = threadIdx.x; asm volatile("" : "+v"(tid_)); const int tid = tid_, wid = __builtin_amdgcn_readfirstlane(tid >> 6), lane = tid & 63, wr = wid >> 2, wc = wid & 3, fr = lane & 15, fq = lane >> 4;
    const int K = g.K, nt = K / BK;
    unsigned voffA[2], voffB[2];
#pragma unroll
    for (int i = 0; i < 2; ++i) { int R, C; stage_rc(tid * 16 + i * 8192, R, C); const int Rb = Epi::PERM ? ((R & ~31) + perm32(R & 31)) : R;
        voffA[i] = (unsigned)(R * K + C) * 2u; voffB[i] = (unsigned)(Rb * K + C) * 2u; }
    const size_t kstep = (size_t)(BK * 2);
    const size_t hstep = (size_t)HALF * K * 2;
    const size_t tstep = 2 * hstep;
    const unsigned ldsw = (unsigned)wid * 1024u;
    const int aoff = lds_byte(wr * 64 + fr, fq * 8), boff = lds_byte(wc * 32 + fr, fq * 8);
#define PG8_SA(b, h) (((b) * 2 + (h)) * HTB)
#define PG8_SB(b, h) ((4 + (b) * 2 + (h)) * HTB)
#define PG8_STAGE(bufoff, gbase, voff) do { _Pragma("unroll") for (int _i = 0; _i < 2; ++_i) \
        __builtin_amdgcn_global_load_lds((const unsigned*)((const char*)(gbase) + (voff)[_i]), (PG8_LAS unsigned*)(lds + (bufoff) + ldsw + _i * 8192), 16, 0, 0); } while (0)
#define PG8_LDA(dst, b, h) do { _Pragma("unroll") for (int m = 0; m < 4; ++m) _Pragma("unroll") for (int k = 0; k < 2; ++k) dst[m][k] = *(const PG8_LAS bf16x8*)(lds + PG8_SA(b, h) + aoff + m * 2048 + k * 1024); } while (0)
#define PG8_LDB(dst, b, h) do { _Pragma("unroll") for (int n = 0; n < 2; ++n) _Pragma("unroll") for (int k = 0; k < 2; ++k) dst[n][k] = *(const PG8_LAS bf16x8*)(lds + PG8_SB(b, h) + boff + n * 2048 + k * 1024); } while (0)
#define PG8_MMA(ai, bj, At, Bt) do { __builtin_amdgcn_s_setprio(1); _Pragma("unroll") for (int m = 0; m < 4; ++m) _Pragma("unroll") for (int n = 0; n < 2; ++n) _Pragma("unroll") for (int k = 0; k < 2; ++k) \
        acc[ai][bj][m][n] = __builtin_amdgcn_mfma_f32_16x16x32_bf16(Bt[n][k], At[m][k], acc[ai][bj][m][n], 0, 0, 0); __builtin_amdgcn_s_setprio(0); } while (0)
#define PG8_WAIT_V(n) asm volatile("s_waitcnt vmcnt(" #n ")" ::: "memory")
#define PG8_WAIT_L(n) asm volatile("s_waitcnt lgkmcnt(" #n ")" ::: "memory")
#define PG8_BAR __builtin_amdgcn_s_barrier()
#define PG8_SCHED __builtin_amdgcn_sched_barrier(0)
    Unit cur, nxt; int ui = 0;
    if (!S.next(0, cur)) return;
    f32x4 acc[2][2][4][2];
#pragma unroll
    for (int a = 0; a < 2; ++a)
#pragma unroll
        for (int b = 0; b < 2; ++b)
#pragma unroll
            for (int m = 0; m < 4; ++m)
#pragma unroll
                for (int n = 0; n < 2; ++n) acc[a][b][m][n] = (f32x4){0.f, 0.f, 0.f, 0.f};
    bf16x8 At[4][2], B0[2][2], B1[2][2];
    const char* cA = (const char*)g.A + (size_t)cur.pm * tstep; const char* cB = (const char*)g.Bt + (size_t)cur.pn * tstep;
    S.a_ready(cur);
    if constexpr (SP2) {
        PG8_STAGE(PG8_SB(0, 0), cB, voffB); PG8_STAGE(PG8_SB(0, 1), cB + hstep, voffB); PG8_STAGE(PG8_SA(0, 0), cA, voffA); PG8_STAGE(PG8_SA(0, 1), cA + hstep, voffA);
        if (wr == 1) PG8_BAR;
        PG8_WAIT_V(2); PG8_BAR;
        PG8_STAGE(PG8_SB(1, 0), cB + kstep, voffB); PG8_STAGE(PG8_SA(1, 0), cA + kstep, voffA); PG8_STAGE(PG8_SB(1, 1), cB + hstep + kstep, voffB);
        PG8_WAIT_V(6); PG8_BAR;
    } else {
        PG8_STAGE(PG8_SB(0, 0), cB, voffB); PG8_STAGE(PG8_SA(0, 0), cA, voffA); PG8_STAGE(PG8_SB(0, 1), cB + hstep, voffB); PG8_STAGE(PG8_SA(0, 1), cA + hstep, voffA);
        if (wr == 1) PG8_BAR;
        PG8_WAIT_V(4); PG8_BAR;
        PG8_STAGE(PG8_SB(1, 0), cB + kstep, voffB); PG8_STAGE(PG8_SA(1, 0), cA + kstep, voffA); PG8_STAGE(PG8_SB(1, 1), cB + hstep + kstep, voffB);
        PG8_WAIT_V(6); PG8_BAR;
    }
    for (;;) {
        const bool has_next = S.next(ui + 1, nxt);
        const char* nA = has_next ? (const char*)g.A + (size_t)nxt.pm * tstep : cA; const char* nB = has_next ? (const char*)g.Bt + (size_t)nxt.pn * tstep : cB;
        for (int t = 0; t < nt; t += 2) {
            const bool last = (t == nt - 2);
            const char* a1 = cA + (size_t)(t + 1) * kstep;
            const char* a2 = last ? nA : cA + (size_t)(t + 2) * kstep; const char* b2 = last ? nB : cB + (size_t)(t + 2) * kstep;
            const char* a3 = a2 + kstep; const char* b3 = b2 + kstep;
            if (last && has_next) S.a_ready(nxt);
            if constexpr (SP2) {
            PG8_LDB(B0, 0, 0); PG8_LDB(B1, 0, 1); PG8_SCHED; PG8_LDA(At, 0, 0); PG8_STAGE(PG8_SA(1, 1), a1 + hstep, voffA);
            PG8_WAIT_V(8); PG8_WAIT_L(0); PG8_BAR; PG8_MMA(0, 0, At, B0); PG8_MMA(0, 1, At, B1); PG8_BAR; PG8_SCHED;
            PG8_LDA(At, 0, 1); PG8_STAGE(PG8_SB(0, 0), b2, voffB); PG8_STAGE(PG8_SB(0, 1), b2 + hstep, voffB); PG8_STAGE(PG8_SA(0, 0), a2, voffA);
            PG8_WAIT_V(8); PG8_WAIT_L(0); PG8_BAR; PG8_MMA(1, 0, At, B0); PG8_MMA(1, 1, At, B1); PG8_BAR; PG8_SCHED;
            PG8_LDB(B0, 1, 0); PG8_LDB(B1, 1, 1); PG8_SCHED; PG8_LDA(At, 1, 0); PG8_STAGE(PG8_SA(0, 1), a2 + hstep, voffA);
            PG8_WAIT_V(8); PG8_WAIT_L(0); PG8_BAR; PG8_MMA(0, 0, At, B0); PG8_MMA(0, 1, At, B1); PG8_BAR; PG8_SCHED;
            PG8_LDA(At, 1, 1); PG8_STAGE(PG8_SB(1, 0), b3, voffB); PG8_STAGE(PG8_SB(1, 1), b3 + hstep, voffB); PG8_STAGE(PG8_SA(1, 0), a3, voffA);
            PG8_WAIT_V(8); PG8_WAIT_L(0); PG8_BAR; PG8_MMA(1, 0, At, B0); PG8_MMA(1, 1, At, B1); PG8_BAR; PG8_SCHED;
            } else {
            PG8_LDB(B0, 0, 0); PG8_SCHED; PG8_LDA(At, 0, 0); PG8_STAGE(PG8_SA(1, 1), a1 + hstep, voffA);
            PG8_WAIT_L(8); PG8_BAR; PG8_WAIT_L(0); PG8_MMA(0, 0, At, B0); PG8_BAR; PG8_SCHED;
            PG8_LDB(B1, 0, 1); PG8_STAGE(PG8_SB(0, 0), b2, voffB);
            PG8_BAR; PG8_WAIT_L(0); PG8_MMA(0, 1, At, B1); PG8_BAR;
            PG8_LDA(At, 0, 1); PG8_STAGE(PG8_SA(0, 0), a2, voffA);
            PG8_BAR; PG8_WAIT_L(0); PG8_MMA(1, 0, At, B0); PG8_BAR; PG8_SCHED;
            PG8_STAGE(PG8_SB(0, 1), b2 + hstep, voffB);
            PG8_WAIT_V(6); PG8_BAR; PG8_MMA(1, 1, At, B1); PG8_BAR;
            PG8_LDB(B0, 1, 0); PG8_SCHED; PG8_LDA(At, 1, 0); PG8_STAGE(PG8_SA(0, 1), a2 + hstep, voffA);
            PG8_WAIT_L(8); PG8_BAR; PG8_WAIT_L(0); PG8_MMA(0, 0, At, B0); PG8_BAR; PG8_SCHED;
            PG8_LDB(B1, 1, 1); PG8_STAGE(PG8_SB(1, 0), b3, voffB);
            PG8_BAR; PG8_WAIT_L(0); PG8_MMA(0, 1, At, B1); PG8_BAR;
            PG8_LDA(At, 1, 1); PG8_STAGE(PG8_SA(1, 0), a3, voffA);
            PG8_BAR; PG8_WAIT_L(0); PG8_MMA(1, 0, At, B0); PG8_BAR; PG8_SCHED;
            PG8_STAGE(PG8_SB(1, 1), b3 + hstep, voffB);
            PG8_WAIT_V(6); PG8_BAR; PG8_MMA(1, 1, At, B1); PG8_BAR;
            }
        }
        if constexpr (ALIGN_EPI) { if (wr == 0) PG8_BAR; }
        if constexpr (!Epi::AFTER_DRAIN) { E(acc, cur, wr, wc, fr, fq); S.done(cur); }
        if (!has_next) break;
#pragma unroll
        for (int a = 0; a < 2; ++a)
#pragma unroll
            for (int b = 0; b < 2; ++b)
#pragma unroll
                for (int m = 0; m < 4; ++m)
#pragma unroll
                    for (int n = 0; n < 2; ++n) acc[a][b][m][n] = (f32x4){0.f, 0.f, 0.f, 0.f};
        cur = nxt; cA = nA; cB = nB; ++ui;
        if constexpr (ALIGN_EPI) { if (wr == 1) PG8_BAR; }
    }
    PG8_WAIT_V(0);
    if constexpr (!ALIGN_EPI) { if (wr == 0) PG8_BAR; }
    PG8_BAR;
    if constexpr (Epi::AFTER_DRAIN) { E.fused(acc, cur, wr, wc, fr, fq, lds, wid, lane); S.done(cur); }
#undef PG8_SA
#undef PG8_SB
#undef PG8_STAGE
#undef PG8_LDA
#undef PG8_LDB
#undef PG8_MMA
#undef PG8_WAIT_V
#undef PG8_WAIT_L
#undef PG8_BAR
#undef PG8_SCHED
}
}
namespace pg8 {
template <class Epi, class Sched, class Src>
__device__ __forceinline__ void gemm_phase2(PG8_LAS unsigned char* lds, const Sched& S, const Src& X, const Epi& E) {
    typedef typename Sched::UnitT UnitT;
    int tid_ = threadIdx.x; asm volatile("" : "+v"(tid_)); const int tid = tid_, wid = __builtin_amdgcn_readfirstlane(tid >> 6), lane = tid & 63, wr = wid >> 2, wc = wid & 3, fr = lane & 15, fq = lane >> 4;
    const int K = X.K, nt = K / BK;
    int sR[2], sC[2]; unsigned voffB[2];
#pragma unroll
    for (int i = 0; i < 2; ++i) { int R, C; stage_rc(tid * 16 + i * 8192, R, C); const int Rb = Epi::PERM ? ((R & ~31) + perm32(R & 31)) : R; sR[i] = R; sC[i] = C; voffB[i] = (unsigned)(Rb * K + C) * 2u; }
    const size_t kstep = (size_t)(BK * 2);
    const size_t hstep = (size_t)HALF * K * 2;
    const unsigned ldsw = (unsigned)wid * 1024u;
    const int aoff = lds_byte(wr * 64 + fr, fq * 8), boff = lds_byte(wc * 32 + fr, fq * 8);
#define PG8_SA(b, h) (((b) * 2 + (h)) * HTB)
#define PG8_SB(b, h) ((4 + (b) * 2 + (h)) * HTB)
#define PG8_STAGE(bufoff, gbase, voff) do { _Pragma("unroll") for (int _i = 0; _i < 2; ++_i) \
        __builtin_amdgcn_global_load_lds((const unsigned*)((const char*)(gbase) + (voff)[_i]), (PG8_LAS unsigned*)(lds + (bufoff) + ldsw + _i * 8192), 16, 0, 0); } while (0)
#define PG8_LDA(dst, b, h) do { _Pragma("unroll") for (int m = 0; m < 4; ++m) _Pragma("unroll") for (int k = 0; k < 2; ++k) dst[m][k] = *(const PG8_LAS bf16x8*)(lds + PG8_SA(b, h) + aoff + m * 2048 + k * 1024); } while (0)
#define PG8_LDB(dst, b, h) do { _Pragma("unroll") for (int n = 0; n < 2; ++n) _Pragma("unroll") for (int k = 0; k < 2; ++k) dst[n][k] = *(const PG8_LAS bf16x8*)(lds + PG8_SB(b, h) + boff + n * 2048 + k * 1024); } while (0)
#define PG8_MMA(ai, bj, At, Bt) do { __builtin_amdgcn_s_setprio(1); _Pragma("unroll") for (int m = 0; m < 4; ++m) _Pragma("unroll") for (int n = 0; n < 2; ++n) _Pragma("unroll") for (int k = 0; k < 2; ++k) \
        acc[ai][bj][m][n] = __builtin_amdgcn_mfma_f32_16x16x32_bf16(Bt[n][k], At[m][k], acc[ai][bj][m][n], 0, 0, 0); __builtin_amdgcn_s_setprio(0); } while (0)
#define PG8_WAIT_V(n) asm volatile("s_waitcnt vmcnt(" #n ")" ::: "memory")
#define PG8_WAIT_L(n) asm volatile("s_waitcnt lgkmcnt(" #n ")" ::: "memory")
#define PG8_BAR __builtin_amdgcn_s_barrier()
#define PG8_SCHED __builtin_amdgcn_sched_barrier(0)
    UnitT cur, nxt; int ui = 0;
    if (!S.next(0, cur)) return;
    f32x4 acc[2][2][4][2];
#pragma unroll
    for (int a = 0; a < 2; ++a)
#pragma unroll
        for (int b = 0; b < 2; ++b)
#pragma unroll
            for (int m = 0; m < 4; ++m)
#pragma unroll
                for (int n = 0; n < 2; ++n) acc[a][b][m][n] = (f32x4){0.f, 0.f, 0.f, 0.f};
    bf16x8 At[4][2], B0[2][2], B1[2][2];
    unsigned oC0[2], oC1[2], oN0[2], oN1[2];
    { unsigned t2[2];
#pragma unroll
      for (int i = 0; i < 2; ++i) { X.a_offs(cur, sR[i], sC[i], t2); oC0[i] = t2[0]; oC1[i] = t2[1]; } }
    const char* const Ab = X.A;
    const char* cB = X.b_base(cur);
    PG8_STAGE(PG8_SB(0, 0), cB, voffB); PG8_STAGE(PG8_SB(0, 1), cB + hstep, voffB); PG8_STAGE(PG8_SA(0, 0), Ab, oC0); PG8_STAGE(PG8_SA(0, 1), Ab, oC1);
    if (wr == 1) PG8_BAR;
    PG8_WAIT_V(2); PG8_BAR;
    PG8_STAGE(PG8_SB(1, 0), cB + kstep, voffB); PG8_STAGE(PG8_SA(1, 0), Ab + kstep, oC0); PG8_STAGE(PG8_SB(1, 1), cB + hstep + kstep, voffB);
    PG8_WAIT_V(6); PG8_BAR;
    for (;;) {
        const bool has_next = S.next(ui + 1, nxt);
        const char* nB = cB;
#pragma unroll
        for (int i = 0; i < 2; ++i) { oN0[i] = oC0[i]; oN1[i] = oC1[i]; }
        if (has_next) { nB = X.b_base(nxt); unsigned t2[2];
#pragma unroll
            for (int i = 0; i < 2; ++i) { X.a_offs(nxt, sR[i], sC[i], t2); oN0[i] = t2[0]; oN1[i] = t2[1]; } }
        for (int t = 0; t < nt; t += 2) {
            const bool last = (t == nt - 2);
            const char* a1 = Ab + (size_t)(t + 1) * kstep;
            const char* a2 = last ? Ab : Ab + (size_t)(t + 2) * kstep; const char* b2 = last ? nB : cB + (size_t)(t + 2) * kstep;
            const char* a3 = a2 + kstep; const char* b3 = b2 + kstep;
            unsigned o20[2], o21[2];
#pragma unroll
            for (int i = 0; i < 2; ++i) { o20[i] = last ? oN0[i] : oC0[i]; o21[i] = last ? oN1[i] : oC1[i]; }
            PG8_LDB(B0, 0, 0); PG8_LDB(B1, 0, 1); PG8_SCHED; PG8_LDA(At, 0, 0); PG8_STAGE(PG8_SA(1, 1), a1, oC1);
            PG8_WAIT_V(8); PG8_WAIT_L(0); PG8_BAR; PG8_MMA(0, 0, At, B0); PG8_MMA(0, 1, At, B1); PG8_BAR; PG8_SCHED;
            PG8_LDA(At, 0, 1); PG8_STAGE(PG8_SB(0, 0), b2, voffB); PG8_STAGE(PG8_SB(0, 1), b2 + hstep, voffB); PG8_STAGE(PG8_SA(0, 0), a2, o20);
            PG8_WAIT_V(8); PG8_WAIT_L(0); PG8_BAR; PG8_MMA(1, 0, At, B0); PG8_MMA(1, 1, At, B1); PG8_BAR; PG8_SCHED;
            PG8_LDB(B0, 1, 0); PG8_LDB(B1, 1, 1); PG8_SCHED; PG8_LDA(At, 1, 0); PG8_STAGE(PG8_SA(0, 1), a2, o21);
            PG8_WAIT_V(8); PG8_WAIT_L(0); PG8_BAR; PG8_MMA(0, 0, At, B0); PG8_MMA(0, 1, At, B1); PG8_BAR; PG8_SCHED;
            PG8_LDA(At, 1, 1); PG8_STAGE(PG8_SB(1, 0), b3, voffB); PG8_STAGE(PG8_SB(1, 1), b3 + hstep, voffB); PG8_STAGE(PG8_SA(1, 0), a3, o20);
            PG8_WAIT_V(8); PG8_WAIT_L(0); PG8_BAR; PG8_MMA(1, 0, At, B0); PG8_MMA(1, 1, At, B1); PG8_BAR; PG8_SCHED;
        }
        if (wr == 0) PG8_BAR;
        E(acc, cur, wr, wc, fr, fq);
        if (!has_next) break;
#pragma unroll
        for (int a = 0; a < 2; ++a)
#pragma unroll
            for (int b = 0; b < 2; ++b)
#pragma unroll
                for (int m = 0; m < 4; ++m)
#pragma unroll
                    for (int n = 0; n < 2; ++n) acc[a][b][m][n] = (f32x4){0.f, 0.f, 0.f, 0.f};
        cur = nxt; cB = nB; ++ui;
#pragma unroll
        for (int i = 0; i < 2; ++i) { oC0[i] = oN0[i]; oC1[i] = oN1[i]; }
        if (wr == 1) PG8_BAR;
    }
    PG8_WAIT_V(0);
    PG8_BAR;
#undef PG8_SA
#undef PG8_SB
#undef PG8_STAGE
#undef PG8_LDA
#undef PG8_LDB
#undef PG8_MMA
#undef PG8_WAIT_V
#undef PG8_WAIT_L
#undef PG8_BAR
#undef PG8_SCHED
}
}
#define GAS __attribute__((address_space(1)))
#define LAS __attribute__((address_space(3)))
typedef unsigned short bf16;
typedef unsigned v4u __attribute__((ext_vector_type(4)));
typedef float f32x4 __attribute__((ext_vector_type(4)));
typedef short bf16x8 __attribute__((ext_vector_type(8)));
typedef GAS unsigned gu32;
typedef GAS unsigned long long gu64;
#define RLX_AGENT __ATOMIC_RELAXED, __HIP_MEMORY_SCOPE_AGENT
#define LDS_WAIT() asm volatile("s_waitcnt lgkmcnt(0)" ::: "memory")
#define VM_WAIT() asm volatile("s_waitcnt vmcnt(0)" ::: "memory")
__device__ __forceinline__ unsigned long long rt() { return __builtin_amdgcn_s_memrealtime(); }
__device__ __forceinline__ unsigned f2bf(float f) { unsigned u = __builtin_bit_cast(unsigned, f); return (u + 0x7fffu + ((u >> 16) & 1u)) >> 16; }
__device__ __forceinline__ unsigned pk2(float lo, float hi) { return f2bf(lo) | (f2bf(hi) << 16); }

#define XB_TMO      128
#define XB_XCNT(j)  (256  + 64 * (j))
#define XB_XSUB(j)  (1280 + 64 * (j))
#define XB_XGEN(j)  (2304 + 64 * (j))
#define XB_TOP      3328
#define XB_TOPGEN   3392
#define XCD_BAR_WORDS 3456
#define XB_SPIN_CAP (1u << 18)

__device__ __forceinline__ unsigned xb_ld(unsigned* p)              { return __hip_atomic_load(p, __ATOMIC_RELAXED, __HIP_MEMORY_SCOPE_AGENT); }
__device__ __forceinline__ unsigned xb_add(unsigned* p, unsigned v) { return __hip_atomic_fetch_add(p, v, __ATOMIC_RELAXED, __HIP_MEMORY_SCOPE_AGENT); }
__device__ __forceinline__ unsigned xb_xcc_id() { return (unsigned)__builtin_amdgcn_s_getreg((3 << 11) | 20) & 0xFu; }
#define XB_SPIN(cond, bar) do { unsigned _sp = 0; while (cond) { __builtin_amdgcn_s_sleep(1); \
    if ((++_sp & 255u) == 0u) { if (xb_ld(&(bar)[XB_TMO])) break; if (_sp > XB_SPIN_CAP) { atomicAdd(&(bar)[XB_TMO], 1u); break; } } } } while (0)

struct XcdBarrier {
    unsigned* bar; unsigned x;
    volatile LAS unsigned* st;
};

__device__ __forceinline__ XcdBarrier xcd_barrier_post(unsigned* bar, volatile LAS unsigned* st) {
    XcdBarrier b; b.bar = bar; b.x = xb_xcc_id(); b.st = st;
    if (threadIdx.x == 0) (void)xb_add(&bar[XB_XCNT(b.x)], 1u);
    return b;
}
__device__ __forceinline__ void xcd_barrier_complete(unsigned* bar, unsigned x, unsigned& nloc, unsigned& nx) {
    const unsigned G = gridDim.x * gridDim.y * gridDim.z;
    unsigned sum, cnt, mine, sp = 0u;
    for (;;) {
        sum = 0u; cnt = 0u; mine = 0u;
#pragma unroll
        for (unsigned j = 0; j < 16; ++j) { const unsigned c = xb_ld(&bar[XB_XCNT(j)]); sum += c; cnt += (c > 0u) ? 1u : 0u; mine = (j == x) ? c : mine; }
        if (sum == G) break;
        __builtin_amdgcn_s_sleep(1);
        if ((++sp & 255u) == 0u) { if (xb_ld(&bar[XB_TMO])) break; if (sp > XB_SPIN_CAP) { atomicAdd(&bar[XB_TMO], 1u); break; } }
    }
    nloc = mine > 0u ? mine : 1u; nx = cnt > 0u ? cnt : 1u;
}

__device__ __forceinline__ void xcd_barrier(const XcdBarrier& b) {
    asm volatile("s_waitcnt vmcnt(0)" ::: "memory");
    __syncthreads();
    if (threadIdx.x == 0) {
        unsigned* bar = b.bar;
        __builtin_amdgcn_s_waitcnt(0);
        unsigned nloc = b.st[0], nx = b.st[1];
        if (nloc == 0u) { xcd_barrier_complete(bar, b.x, nloc, nx); b.st[0] = nloc; b.st[1] = nx; }
        const unsigned old = xb_add(&bar[XB_XSUB(b.x)], 1u);
        const unsigned gen = old / nloc;
        if (old + 1u == (gen + 1u) * nloc) {
            __builtin_amdgcn_fence(__ATOMIC_RELEASE, "agent");
            asm volatile("s_waitcnt vmcnt(0)" ::: "memory");
            const unsigned og = xb_add(&bar[XB_TOP], 1u);
            const unsigned tg = og / nx;
            if (og + 1u == (tg + 1u) * nx) xb_add(&bar[XB_TOPGEN], 1u);
            else XB_SPIN(xb_ld(&bar[XB_TOPGEN]) == tg, bar);
            __builtin_amdgcn_fence(__ATOMIC_ACQUIRE, "agent");
            xb_add(&bar[XB_XGEN(b.x)], 1u);
            asm volatile("s_waitcnt vmcnt(0)" ::: "memory");
        } else {
            XB_SPIN(xb_ld(&bar[XB_XGEN(b.x)]) == gen, bar);
            __builtin_amdgcn_fence(__ATOMIC_ACQUIRE, "agent");
            asm volatile("s_waitcnt vmcnt(0)" ::: "memory");
        }
    }
    __syncthreads();
}
namespace att {
typedef short bf16x8 __attribute__((ext_vector_type(8)));
typedef float f32x16 __attribute__((ext_vector_type(16)));
typedef float f32x4 __attribute__((ext_vector_type(4)));
typedef unsigned u32x4 __attribute__((ext_vector_type(4)));
typedef short v4i16_t __attribute__((ext_vector_type(4)));
typedef short s16x4 __attribute__((ext_vector_type(4)));
#define ATT_LAS __attribute__((address_space(3)))
constexpr int SLOTB = 8192;
constexpr int L_K = 0, L_V = 2 * SLOTB, L_WS = 4 * SLOTB, L_OST = L_WS + 8 * 256, L_CB = L_OST + 8 * 4096, L_BYTES = L_CB + 32768;
constexpr int D_K = 0, D_V = 6 * SLOTB, D_WS = 12 * SLOTB, D_OST = D_WS + 8 * 256, D_BYTES = D_OST + 8 * 4096;
__device__ __forceinline__ int crow(int r, int hi) { return (r & 3) + 8 * (r >> 2) + 4 * hi; }
__device__ __forceinline__ unsigned cvtpk(float lo, float hi) { unsigned r; asm volatile("v_cvt_pk_bf16_f32 %0, %1, %2" : "=v"(r) : "v"(lo), "v"(hi)); return r; }

struct Unit {
    const unsigned short* Q; const unsigned short* K; const unsigned short* V;
    int qrow0, qstride, krow0, kstride;
    int nt0, nt1;
    int ioff, W;
    ATT_LAS const float* bias;
    unsigned short* O; int opitch;
    float* lse;
};
struct State { float m, l; f32x16 o[2]; };

template <bool FOX>
__device__ __forceinline__ void tile_step(State& S, const bf16x8 (&qr)[4], ATT_LAS const unsigned char* Kt, ATT_LAS const unsigned char* Vt, ATT_LAS float* wsf, const Unit& U, int t, int lo_i, int lane) {
    const int r32 = lane & 31, hi = lane >> 5;
    ATT_LAS const unsigned char* Kb = Kt + hi * 1024 + r32 * 16;
    ATT_LAS const unsigned char* Vb = Vt + ((lane >> 4) & 1) * 32 + (lane & 3) * 8 + (4 * hi + ((lane & 15) >> 2)) * 64;
    f32x16 p0, p1;
    if (FOX) { ATT_LAS const float* Bb = U.bias + 64 * t + 4 * hi;
#pragma unroll
        for (int g = 0; g < 4; ++g) { const f32x4 b0 = *(ATT_LAS const f32x4*)(Bb + 8 * g), b1 = *(ATT_LAS const f32x4*)(Bb + 32 + 8 * g);
#pragma unroll
            for (int i = 0; i < 4; ++i) { p0[4 * g + i] = b0[i]; p1[4 * g + i] = b1[i]; } }
    } else {
#pragma unroll
        for (int r = 0; r < 16; ++r) { p0[r] = 0.f; p1[r] = 0.f; }
    }
#pragma unroll
    for (int d0 = 0; d0 < 4; ++d0) {
        const bf16x8 a0 = *(ATT_LAS const bf16x8*)(Kb + d0 * 2048), a1 = *(ATT_LAS const bf16x8*)(Kb + d0 * 2048 + 512);
        p0 = __builtin_amdgcn_mfma_f32_32x32x16_bf16(a0, qr[d0], p0, 0, 0, 0);
        p1 = __builtin_amdgcn_mfma_f32_32x32x16_bf16(a1, qr[d0], p1, 0, 0, 0);
    }
    const bool full = (lo_i - (64 * t + 63) >= 0) && (FOX || (lo_i + 31 - 64 * t <= U.W));
    if (!full) {
        const int dl = lo_i + r32 - 64 * t - 4 * hi;
#pragma unroll
        for (int r = 0; r < 16; ++r) { const int d0v = dl - ((r & 3) + 8 * (r >> 2)), d1v = d0v - 32;
            if (d0v < 0 || (!FOX && d0v > U.W)) p0[r] = -INFINITY;
            if (d1v < 0 || (!FOX && d1v > U.W)) p1[r] = -INFINITY; }
    }
    float tm = fmaxf(p0[0], p1[0]);
#pragma unroll
    for (int r = 1; r < 16; ++r) tm = fmaxf(tm, fmaxf(p0[r], p1[r]));
    tm = fmaxf(tm, __shfl_xor(tm, 32));
    const float mn = fmaxf(S.m, tm);
    const float alpha = __builtin_amdgcn_exp2f(S.m - mn);
    S.m = mn;
    float ls = 0.f;
#pragma unroll
    for (int r = 0; r < 16; ++r) { p0[r] = __builtin_amdgcn_exp2f(p0[r] - mn); p1[r] = __builtin_amdgcn_exp2f(p1[r] - mn); ls += p0[r] + p1[r]; }
    S.l = S.l * alpha + ls;
    if (hi == 0) wsf[r32] = alpha;
    u32x4 pw[4];
#pragma unroll
    for (int i = 0; i < 4; ++i) { pw[0][i] = cvtpk(p0[2 * i], p0[2 * i + 1]); pw[1][i] = cvtpk(p0[8 + 2 * i], p0[9 + 2 * i]); pw[2][i] = cvtpk(p1[2 * i], p1[2 * i + 1]); pw[3][i] = cvtpk(p1[8 + 2 * i], p1[9 + 2 * i]); }
#pragma unroll
    for (int g = 0; g < 4; ++g) { const f32x4 a4 = *(ATT_LAS const f32x4*)(wsf + 8 * g + 4 * hi);
#pragma unroll
        for (int i = 0; i < 4; ++i) { S.o[0][4 * g + i] *= a4[i]; S.o[1][4 * g + i] *= a4[i]; } }
#pragma unroll
    for (int d0 = 0; d0 < 2; ++d0)
#pragma unroll
        for (int ks = 0; ks < 4; ++ks) {
            const s16x4 vlo = __builtin_bit_cast(s16x4, __builtin_amdgcn_ds_read_tr16_b64_v4i16((ATT_LAS v4i16_t*)(Vb + d0 * 4096 + ks * 1024)));
            const s16x4 vhi = __builtin_bit_cast(s16x4, __builtin_amdgcn_ds_read_tr16_b64_v4i16((ATT_LAS v4i16_t*)(Vb + d0 * 4096 + ks * 1024 + 512)));
            const bf16x8 vf = (bf16x8){vlo[0], vlo[1], vlo[2], vlo[3], vhi[0], vhi[1], vhi[2], vhi[3]};
            S.o[d0] = __builtin_amdgcn_mfma_f32_32x32x16_bf16(__builtin_bit_cast(bf16x8, pw[ks]), vf, S.o[d0], 0, 0, 0);
        }
}
template <bool FOX>
__device__ __forceinline__ void unit_epilogue(State& S, ATT_LAS float* wsf, ATT_LAS unsigned short* stg, const Unit& U, int wid, int lane) {
    const int r32 = lane & 31, hi = lane >> 5;
    const float L = S.l + __shfl_xor(S.l, 32);
    if (hi == 0) wsf[r32] = L;
    if (!FOX) { if (hi == 0) U.lse[(size_t)(U.qrow0 + U.qstride * (32 * wid + r32)) * 8] = S.m + __builtin_amdgcn_logf(L); }
    float rli[16];
#pragma unroll
    for (int g = 0; g < 4; ++g) { const f32x4 a4 = *(ATT_LAS const f32x4*)(wsf + 8 * g + 4 * hi);
#pragma unroll
        for (int i = 0; i < 4; ++i) rli[4 * g + i] = __builtin_amdgcn_rcpf(a4[i]); }
#pragma unroll
    for (int r = 0; r < 16; ++r) { const int orow = crow(r, hi);
#pragma unroll
        for (int d0 = 0; d0 < 2; ++d0) stg[orow * 64 + d0 * 32 + r32] = (unsigned short)(cvtpk(S.o[d0][r] * rli[r], 0.f) & 0xffffu); }
#pragma unroll
    for (int i = 0; i < 4; ++i) { const int row = i * 8 + (lane >> 3), ch = lane & 7; const u32x4 v = *(ATT_LAS const u32x4*)(stg + row * 64 + ch * 8);
        *(u32x4*)(U.O + (size_t)(U.qrow0 + U.qstride * (32 * wid + row)) * U.opitch + ch * 8) = v; }
}
__device__ __forceinline__ void load_q(bf16x8 (&qr)[4], const Unit& U, int wid, int lane) {
    const unsigned short* qp = U.Q + (size_t)(U.qrow0 + U.qstride * (32 * wid + (lane & 31))) * 512 + (lane >> 5) * 8;
#pragma unroll
    for (int d0 = 0; d0 < 4; ++d0) qr[d0] = *(const bf16x8*)(qp + d0 * 16);
}

__device__ __forceinline__ void fox_unit(const Unit& U, ATT_LAS unsigned char* lds) {
    int tid_ = threadIdx.x; asm volatile("" : "+v"(tid_)); const int tid = tid_, lane = tid & 63; const int wid = __builtin_amdgcn_readfirstlane(tid >> 6);
    bf16x8 qr[4]; load_q(qr, U, wid, lane);
    const int lo_i = 32 * wid + U.ioff;
    const int wt1 = min(U.nt1, ((lo_i + 31) >> 6) + 1);
    State S; S.m = -INFINITY; S.l = 0.f;
#pragma unroll
    for (int r = 0; r < 16; ++r) { S.o[0][r] = 0.f; S.o[1][r] = 0.f; }
    const int krow_k = lane, krow_v = 16 * (wid & 3) + (lane >> 2);
    const unsigned short* kbase = U.K + wid * 8;
    const unsigned short* vbase = U.V + (wid >> 2) * 32 + (lane & 3) * 8;
    ATT_LAS unsigned char* kdst = lds + L_K + wid * 1024 + lane * 16;
    ATT_LAS unsigned char* vdst = lds + L_V + wid * 1024 + lane * 16;
    ATT_LAS float* wsf = (ATT_LAS float*)(lds + L_WS) + wid * 64;
    u32x4 kreg, vreg;
#define ATT_LOAD(t) do { kreg = *(const u32x4*)(kbase + (size_t)(U.krow0 + U.kstride * (64 * (t) + krow_k)) * 512); \
                         vreg = *(const u32x4*)(vbase + (size_t)(U.krow0 + U.kstride * (64 * (t) + krow_v)) * 512); } while (0)
#define ATT_WRITE(slot) do { *(ATT_LAS u32x4*)(kdst + (slot) * SLOTB) = kreg; *(ATT_LAS u32x4*)(vdst + (slot) * SLOTB) = vreg; } while (0)
    ATT_LOAD(U.nt0); ATT_WRITE(0);
    __syncthreads();
    for (int t = U.nt0; t < U.nt1; ++t) {
        const int slot = (t - U.nt0) & 1; const bool more = (t + 1 < U.nt1);
        if (more) ATT_LOAD(t + 1);
        if (t < wt1) tile_step<true>(S, qr, lds + L_K + slot * SLOTB, lds + L_V + slot * SLOTB, wsf, U, t, lo_i, lane);
        if (more) ATT_WRITE(slot ^ 1);
        __syncthreads();
    }
#undef ATT_LOAD
#undef ATT_WRITE
    unit_epilogue<true>(S, wsf, (ATT_LAS unsigned short*)(lds + L_OST) + wid * 2048, U, wid, lane);
    __syncthreads();
}

struct Pre { u32x4 k[6], v[6]; };
__device__ __forceinline__ void dil_prefetch(Pre& P, const Unit& U) {
    int tid_ = threadIdx.x; asm volatile("" : "+v"(tid_)); const int tid = tid_, lane = tid & 63; const int wid = __builtin_amdgcn_readfirstlane(tid >> 6);
    const int krow_k = lane, krow_v = 16 * (wid & 3) + (lane >> 2);
    const unsigned short* kbase = U.K + wid * 8;
    const unsigned short* vbase = U.V + (wid >> 2) * 32 + (lane & 3) * 8;
#pragma unroll
    for (int j = 0; j < 6; ++j) if (j >= U.nt0) {
        P.k[j] = *(const u32x4*)(kbase + (size_t)(U.krow0 + U.kstride * (64 * j + krow_k)) * 512);
        P.v[j] = *(const u32x4*)(vbase + (size_t)(U.krow0 + U.kstride * (64 * j + krow_v)) * 512); }
}
__device__ __forceinline__ void dil_stage(const Pre& P, const Unit& U, ATT_LAS unsigned char* lds) {
    int tid_ = threadIdx.x; asm volatile("" : "+v"(tid_)); const int tid = tid_, lane = tid & 63; const int wid = __builtin_amdgcn_readfirstlane(tid >> 6);
    ATT_LAS unsigned char* kdst = lds + D_K + wid * 1024 + lane * 16;
    ATT_LAS unsigned char* vdst = lds + D_V + wid * 1024 + lane * 16;
#pragma unroll
    for (int j = 0; j < 6; ++j) if (j >= U.nt0) { *(ATT_LAS u32x4*)(kdst + j * SLOTB) = P.k[j]; *(ATT_LAS u32x4*)(vdst + j * SLOTB) = P.v[j]; }
}
__device__ __forceinline__ void dil_compute(const Unit& U, ATT_LAS unsigned char* lds) {
    int tid_ = threadIdx.x; asm volatile("" : "+v"(tid_)); const int tid = tid_, lane = tid & 63; const int wid = __builtin_amdgcn_readfirstlane(tid >> 6);
    bf16x8 qr[4]; load_q(qr, U, wid, lane);
    const int lo_i = 32 * wid + U.ioff;
    const int wt0 = max(U.nt0, (lo_i - U.W) >> 6), wt1 = min(U.nt1, ((lo_i + 31) >> 6) + 1);
    State S; S.m = -INFINITY; S.l = 0.f;
#pragma unroll
    for (int r = 0; r < 16; ++r) { S.o[0][r] = 0.f; S.o[1][r] = 0.f; }
    ATT_LAS float* wsf = (ATT_LAS float*)(lds + D_WS) + wid * 64;
    for (int t = wt0; t < wt1; ++t) tile_step<false>(S, qr, lds + D_K + t * SLOTB, lds + D_V + t * SLOTB, wsf, U, t, lo_i, lane);
    unit_epilogue<false>(S, wsf, (ATT_LAS unsigned short*)(lds + D_OST) + wid * 2048, U, wid, lane);
}
#undef ATT_LAS
}
constexpr int NWAVES = 8;
constexpr int RING_OFF = 0, RING_BYTES = 131072;
constexpr int LDSCTL_OFF = 147456, MISC_OFF = LDSCTL_OFF + 320;
constexpr int QS_OFF = MISC_OFF + 128;
constexpr int LDS_BYTES = 163840;
constexpr int CW_TMO = 0, CW_CODE = 1;
constexpr int CW_BAR = 4096;
constexpr int CW_COUNT = 8192;
constexpr int CW_QUEUE = 8448;
static_assert((CW_BAR + XCD_BAR_WORDS) * 4 <= (int)CTL_ZERO_BYTES && (CW_QUEUE + 16 * 64) * 4 <= (int)CTL_ZERO_BYTES, "CTL words inside the memset region");

struct Frame {
    LAS unsigned char* lds;
    volatile LAS unsigned* MISC;
    gu32* ctl;
    int tid, lane, wave;
    int vcu, G;
};
__device__ __forceinline__ void frame_refresh(Frame& F) { int t = threadIdx.x; asm volatile("" : "+v"(t)); F.tid = t; F.lane = t & 63; F.wave = __builtin_amdgcn_readfirstlane(t >> 6); }
__device__ __forceinline__ float wave_sum(float v) {
#pragma unroll
    for (int o = 1; o < 64; o <<= 1) v += __shfl_xor(v, o);
    return v;
}
__device__ __forceinline__ float wave_max(float v) {
#pragma unroll
    for (int o = 1; o < 64; o <<= 1) v = fmaxf(v, __shfl_xor(v, o));
    return v;
}

struct MapIdent { int off; __device__ __forceinline__ int operator()(int n) const { return off + n; } };
struct MapWin { __device__ __forceinline__ int operator()(int c) const { const int tile = c >> 8, l = c & 255; return tile * 256 + 128 * ((l >> 5) & 1) + 32 * (l >> 6) + (l & 31); } };
struct MapGU { int base; __device__ __forceinline__ int operator()(int c) const { return base + (c >> 7) * 256 + (c & 127); } };
template <class RowMap>
__device__ __forceinline__ void p0_tile(const float* W, int K, int ldw, int nblk, bf16* WT, const RowMap& rm, LAS float* scr, int item, int lane) {
    const int kb = item / nblk, nb = item % nblk, k0 = 64 * kb, n0 = 64 * nb;
    f32x4 v[16];
    const float* src = W + (size_t)(k0 + (lane >> 4)) * ldw + n0 + 4 * (lane & 15);
#pragma unroll
    for (int i = 0; i < 16; ++i) v[i] = *(const f32x4*)(src + (size_t)(4 * i) * ldw);
#pragma unroll
    for (int i = 0; i < 16; ++i) { LAS float* d = scr + (4 * i + (lane >> 4)) * 65 + 4 * (lane & 15); d[0] = v[i].x; d[1] = v[i].y; d[2] = v[i].z; d[3] = v[i].w; }
    LDS_WAIT(); asm volatile("" ::: "memory");
    const int c = lane & 7;
#pragma unroll
    for (int j = 0; j < 8; ++j) { const int n = (lane >> 3) + 8 * j; const LAS float* s = scr + (8 * c) * 65 + n;
        v4u o; o.x = pk2(s[0 * 65], s[1 * 65]); o.y = pk2(s[2 * 65], s[3 * 65]); o.z = pk2(s[4 * 65], s[5 * 65]); o.w = pk2(s[6 * 65], s[7 * 65]);
        *(GAS v4u*)(WT + (size_t)rm(n0 + n) * K + k0 + 8 * c) = o; }
    LDS_WAIT(); asm volatile("" ::: "memory");
}

struct P0Args { const float* x; const float* norm_mix; const float* w_in; const float* b_forget; const float* w_out; const float* w_gate; const float* w_up; const float* w_down;
                bf16* Win_t; bf16* Wo_t; bf16* Wgu_t; bf16* Wd_t; bf16* XN; float* logf; float* cosT; float* sinT; const float* g0; const float* g1; const float* g2; const float* g3; float* gtab; };

__device__ __forceinline__ void p0_prologue(Frame& F, const P0Args& A) {
    frame_refresh(F);
    const int gw = F.vcu * NWAVES + F.wave, NGW = F.G * NWAVES;
    {
        LAS float* slab = (LAS float*)(F.lds + RING_OFF);
        for (int k = F.tid; k < 1024; k += NWAVES * 64) {
            const f32x4 a = *(const f32x4*)(A.w_in + (size_t)k * D_PROJ + 3072), b = *(const f32x4*)(A.w_in + (size_t)k * D_PROJ + 3076);
            const int j = k >> 8, ln = (k & 255) >> 2, i = k & 3; LAS float* d = slab + (size_t)(((j * 4 + i) * 64 + ln) * 8);
            *(LAS f32x4*)d = a; *(LAS f32x4*)(d + 4) = b;
        }
        __syncthreads();
        f32x4 g4[4];
#pragma unroll
        for (int j = 0; j < 4; ++j) g4[j] = *(const f32x4*)(A.norm_mix + 4 * F.lane + 256 * j);
        for (int rep = 0; rep < (REP == 8 ? 2 : 1); ++rep)
        for (int m = gw; m < NT; m += NGW) {
            const GAS f32x4* xr = (const GAS f32x4*)(A.x + (size_t)m * D_MODEL) + F.lane;
            f32x4 v[4]; float ss = 0.f;
#pragma unroll
            for (int j = 0; j < 4; ++j) { v[j] = xr[64 * j]; ss += (v[j].x * v[j].x + v[j].y * v[j].y) + (v[j].z * v[j].z + v[j].w * v[j].w); }
            const float rs = 1.0f / sqrtf(wave_sum(ss) * (1.f / D_MODEL) + EPS);
            float fa[8];
#pragma unroll
            for (int c = 0; c < 8; ++c) fa[c] = 0.f;
            GAS unsigned long long* o8 = (GAS unsigned long long*)(A.XN + (size_t)m * D_MODEL) + F.lane;
#pragma unroll
            for (int j = 0; j < 4; ++j) {
                v[j] = v[j] * rs * g4[j];
                o8[64 * j] = (unsigned long long)pk2(v[j].x, v[j].y) | ((unsigned long long)pk2(v[j].z, v[j].w) << 32);
#pragma unroll
                for (int i = 0; i < 4; ++i) { const LAS float* d = slab + (size_t)(((j * 4 + i) * 64 + F.lane) * 8); const f32x4 w0 = *(const LAS f32x4*)d, w1 = *(const LAS f32x4*)(d + 4); const float xv = v[j][i];
                    fa[0] += xv * w0.x; fa[1] += xv * w0.y; fa[2] += xv * w0.z; fa[3] += xv * w0.w; fa[4] += xv * w1.x; fa[5] += xv * w1.y; fa[6] += xv * w1.z; fa[7] += xv * w1.w; }
            }
#pragma unroll
            for (int c = 0; c < 8; ++c) fa[c] = wave_sum(fa[c]);
            if (F.lane < 8) { float z = fa[0];
#pragma unroll
                for (int c = 1; c < 8; ++c) z = (F.lane == c) ? fa[c] : z;
                z += A.b_forget[F.lane];
                const float lf = fminf(z, 0.f) - log1pf(expf(-fabsf(z)));
                const int b = m / SEQ, t = m % SEQ; A.logf[(size_t)(b * NH + F.lane) * SEQ + t] = lf; }
        }
        __syncthreads();
    }
    if (blockIdx.x == 0 && F.tid < 64) { const int l = F.tid; A.gtab[l] = A.g0[l] * QSCALE; A.gtab[64 + l] = A.g1[l]; A.gtab[128 + l] = A.g2[l] * QSCALE; A.gtab[192 + l] = A.g3[l]; }
    for (int idx = (F.vcu * NWAVES * 64) + F.tid; idx < SEQ * 32; idx += F.G * NWAVES * 64) {
        const int pos = idx >> 5, i = idx & 31;
        const float inv_freq = 1.0f / exp2f(((float)(2 * i) / 64.0f) * 13.287712379549449f);
        const float ang = (float)pos * inv_freq;
        const double a = (double)ang; const double k = rint(a * 0.15915494309189535); const float rf = (float)(a - k * 6.283185307179586);
        A.cosT[idx] = cosf(rf); A.sinT[idx] = sinf(rf);
    }
    {
        LAS float* scr = (LAS float*)(F.lds + RING_OFF) + F.wave * (64 * 65);
        constexpr int I_IN = 16 * 48, I_O = 16 * 16, I_G = 16 * 8, I_D = 8 * 16;
        constexpr int NITEMS = I_IN + I_O + NE * (2 * I_G + I_D);
        for (int rep = 0; rep < (REP == 9 ? 2 : 1); ++rep)
        for (int it = gw; it < NITEMS; it += NGW) {
            int r = it;
            if (r < I_IN) { p0_tile(A.w_in, 1024, D_PROJ, 48, A.Win_t, MapWin{}, scr, r, F.lane); continue; } r -= I_IN;
            if (r < I_O) { p0_tile(A.w_out, 1024, 1024, 16, A.Wo_t, MapIdent{0}, scr, r, F.lane); continue; } r -= I_O;
            const int e = r / (2 * I_G + I_D); r -= e * (2 * I_G + I_D);
            if (r < I_G) { p0_tile(A.w_gate + (size_t)e * 1024 * 512, 1024, 512, 8, A.Wgu_t, MapGU{e * 1024}, scr, r, F.lane); continue; } r -= I_G;
            if (r < I_G) { p0_tile(A.w_up + (size_t)e * 1024 * 512, 1024, 512, 8, A.Wgu_t, MapGU{e * 1024 + 128}, scr, r, F.lane); continue; } r -= I_G;
            p0_tile(A.w_down + (size_t)e * 512 * 1024, 512, 1024, 16, A.Wd_t, MapIdent{e * 1024}, scr, r, F.lane);
        }
    }
}
constexpr size_t WS_DILP1 = WS_XN, WS_DILP2 = WS_XN + 16 * MiB;
struct P2Args { const bf16* qkv; const float* logf; bf16* A2; bf16* dilp1; bf16* dilp2; float* lse; const float* gtab; };
__device__ __forceinline__ void dil_desc(att::Unit& U, int u, int b, int h, const unsigned short* QA, const P2Args& A) {
    const int pat = u >> 5, blk = u & 31;
    const int dsh = 2 * pat, d = 1 << dsh, bpc = 32 >> dsh, r = blk / bpc, n = blk % bpc;
    U.Q = QA + 3 * QKV_TSTRIDE; U.K = QA + 4 * QKV_TSTRIDE; U.V = QA + 5 * QKV_TSTRIDE;
    U.qrow0 = b * SEQ + r + d * 256 * n; U.qstride = d; U.krow0 = b * SEQ + r + d * (256 * n - 128); U.kstride = d; U.nt0 = (n == 0) ? 2 : 0; U.nt1 = 6; U.ioff = 128; U.W = 128;
    U.bias = nullptr;
    if (pat == 0) { U.O = (unsigned short*)A.A2 + 512 + h * 64; U.opitch = 1024; } else { U.O = (unsigned short*)(pat == 1 ? A.dilp1 : A.dilp2) + h * 64; U.opitch = 512; }
    U.lse = A.lse + (size_t)pat * NT * 8 + h;
}
__device__ __forceinline__ void p2_attention(Frame& F, const P2Args& A) {
    frame_refresh(F);
    const int bh = F.vcu >> 4, b = bh >> 3, h = bh & 7;
    LAS unsigned char* lds = F.lds + RING_OFF;
    LAS float* cbL = (LAS float*)(lds + att::L_CB);
    {
        const float* lf = A.logf + (size_t)bh * SEQ + F.tid * 16;
        float v[16];
#pragma unroll
        for (int j = 0; j < 4; ++j) { const f32x4 x = *(const f32x4*)(lf + 4 * j); v[4 * j] = x.x; v[4 * j + 1] = x.y; v[4 * j + 2] = x.z; v[4 * j + 3] = x.w; }
        double loc = 0.0;
#pragma unroll
        for (int i = 0; i < 16; ++i) loc += (double)v[i];
        double inc = loc;
#pragma unroll
        for (int o = 1; o < 64; o <<= 1) { const double n = __shfl_up(inc, o); if (F.lane >= o) inc += n; }
        LAS double* wtot = (LAS double*)(lds + att::L_WS);
        if (F.lane == 63) wtot[F.wave] = inc;
        __syncthreads();
        double run = inc - loc;
        for (int w = 0; w < F.wave; ++w) run += wtot[w];
#pragma unroll
        for (int i = 0; i < 16; ++i) { run += (double)v[i]; cbL[F.tid * 16 + i] = (float)(-run * (double)LOG2E); }
    }
    float thr;
    { const float mq = wave_max(fabsf(A.gtab[F.lane])), mk = wave_max(fabsf(A.gtab[64 + F.lane])); const float B = 64.0f * mq * mk * 1.02f; thr = -(151.0f + 2.0f * B); }
    const unsigned short* QA = (const unsigned short*)A.qkv + h * 64;
    LAS int* qs = (LAS int*)(F.lds + QS_OFF);
    gu32* q = F.ctl + CW_QUEUE + bh * 64;
    if (F.tid == 0) { qs[0] = (int)__hip_atomic_fetch_add(q, 1u, RLX_AGENT); qs[1] = (int)__hip_atomic_fetch_add(q, 1u, RLX_AGENT); }
    __syncthreads();
    int cur = qs[0], nxt = qs[1], it = 0;
    bool pre_valid = false; att::Pre P;
    while (cur < 128) {
        if (F.tid == 0) qs[2 + (it & 1)] = (int)__hip_atomic_fetch_add(q, 1u, RLX_AGENT);
        if (cur < 32) {
            const int qb = 31 - cur;
            att::Unit U;
            U.Q = QA; U.K = QA + QKV_TSTRIDE; U.V = QA + 2 * QKV_TSTRIDE;
            U.qrow0 = b * SEQ + 256 * qb; U.qstride = 1; U.krow0 = b * SEQ; U.kstride = 1; U.ioff = 256 * qb; U.W = 1 << 30;
            U.bias = cbL; U.O = (unsigned short*)A.A2 + h * 64; U.opitch = 1024; U.lse = nullptr;
            { const float cbt = cbL[256 * qb]; int lo = 0, hi = 4 * qb;
              while (lo < hi) { const int mid = (lo + hi) >> 1; const bool ok = (cbL[64 * mid + 63] - cbt) >= thr; if (__builtin_amdgcn_readfirstlane((int)ok)) hi = mid; else lo = mid + 1; }
              U.nt0 = lo; U.nt1 = 4 * qb + 4; }
            att::fox_unit(U, lds);
        } else {
            att::Unit U; dil_desc(U, cur - 32, b, h, QA, A);
            if (!pre_valid) att::dil_prefetch(P, U);
            att::dil_stage(P, U, lds);
            __syncthreads();
            pre_valid = (nxt >= 32 && nxt < 128);
            if (pre_valid) { att::Unit Un; dil_desc(Un, nxt - 32, b, h, QA, A); att::dil_prefetch(P, Un); }
            att::dil_compute(U, lds);
            __syncthreads();
        }
        cur = nxt; nxt = qs[2 + (it & 1)]; ++it;
    }
}
__device__ __forceinline__ float bf_lo(unsigned w) { return __uint_as_float(w << 16); }
__device__ __forceinline__ float bf_hi(unsigned w) { return __uint_as_float(w & 0xffff0000u); }
struct P25Args { bf16* A2; const bf16* dilp1; const bf16* dilp2; const float* lse; const float* gf; const float* gd; };
__device__ __forceinline__ void p25_combine(Frame& F, const P25Args& A) {
    frame_refresh(F);
    const int gw = F.vcu * NWAVES + F.wave, NGW = F.G * NWAVES;
    float ga[8], gb[8];
#pragma unroll
    for (int j = 0; j < 2; ++j) { const f32x4 x = *(const f32x4*)(A.gf + 8 * F.lane + 4 * j), y = *(const f32x4*)(A.gd + 8 * F.lane + 4 * j);
        ga[4 * j] = x.x; ga[4 * j + 1] = x.y; ga[4 * j + 2] = x.z; ga[4 * j + 3] = x.w; gb[4 * j] = y.x; gb[4 * j + 1] = y.y; gb[4 * j + 2] = y.z; gb[4 * j + 3] = y.w; }
    const int head = F.lane >> 3;
    for (int m = gw; m < NT; m += NGW) {
        GAS v4u* rowA = (GAS v4u*)(A.A2 + (size_t)m * 1024) + F.lane;
        const v4u fa = rowA[0], d0 = rowA[64], d1 = *((const GAS v4u*)(A.dilp1 + (size_t)m * 512) + F.lane), d2 = *((const GAS v4u*)(A.dilp2 + (size_t)m * 512) + F.lane);
        const float l0 = A.lse[(size_t)m * 8 + head], l1 = A.lse[(size_t)(NT + m) * 8 + head], l2 = A.lse[(size_t)(2 * NT + m) * 8 + head];
        const float mx = fmaxf(l0, fmaxf(l1, l2));
        float w0 = __builtin_amdgcn_exp2f(l0 - mx), w1 = __builtin_amdgcn_exp2f(l1 - mx), w2 = __builtin_amdgcn_exp2f(l2 - mx);
        const float inv = 1.0f / (w0 + w1 + w2); w0 *= inv; w1 *= inv; w2 *= inv;
        float xa[8], xb[8]; float sa = 0.f, sb = 0.f;
#pragma unroll
        for (int j = 0; j < 4; ++j) {
            xa[2 * j] = bf_lo(fa[j]); xa[2 * j + 1] = bf_hi(fa[j]);
            xb[2 * j] = w0 * bf_lo(d0[j]) + w1 * bf_lo(d1[j]) + w2 * bf_lo(d2[j]); xb[2 * j + 1] = w0 * bf_hi(d0[j]) + w1 * bf_hi(d1[j]) + w2 * bf_hi(d2[j]);
            sa += xa[2 * j] * xa[2 * j] + xa[2 * j + 1] * xa[2 * j + 1]; sb += xb[2 * j] * xb[2 * j] + xb[2 * j + 1] * xb[2 * j + 1];
        }
        const float ra = 1.0f / sqrtf(wave_sum(sa) * (1.0f / 512.0f) + EPS), rb = 1.0f / sqrtf(wave_sum(sb) * (1.0f / 512.0f) + EPS);
        v4u oa, ob;
#pragma unroll
        for (int j = 0; j < 4; ++j) { oa[j] = pk2(xa[2 * j] * ra * ga[2 * j], xa[2 * j + 1] * ra * ga[2 * j + 1]); ob[j] = pk2(xb[2 * j] * rb * gb[2 * j], xb[2 * j + 1] * rb * gb[2 * j + 1]); }
        rowA[0] = oa; rowA[64] = ob;
    }
}
constexpr int CAP = 16384;
constexpr size_t WS_PAIRTOK = WS_WIN;
constexpr size_t WS_PAIRGATE = WS_WIN + 2 * MiB;
constexpr size_t WS_TOKPAIR = WS_ROUTE;
constexpr size_t WS_HN = WS_XN;
constexpr size_t WS_HMID = WS_QKV;
constexpr size_t WS_Y = WS_QKV + 40 * MiB;
static_assert(WS_Y + (size_t)40960 * 1024 * 2 <= WS_END, "ws map");
constexpr int MOE_CNT_OFF = MISC_OFF + 256, MOE_PT_OFF = MOE_CNT_OFF + 128, MOE_LCNT_OFF = MOE_PT_OFF + 256, MOE_LBASE_OFF = MOE_LCNT_OFF + 128, MOE_REC_OFF = MOE_LBASE_OFF + 128;
static_assert(MOE_REC_OFF + 64 * 32 <= LDS_BYTES, "LDS control region");

struct P35Args { const float* h; const float* gffn; const float* wrg; const float* brg; const float* wre; const float* bre; bf16* HN; int* pair_tok; float* pair_gate; int* tok_pair; gu32* gcount; };
__device__ __forceinline__ void p35_router(Frame& F, const P35Args& A) {
    frame_refresh(F);
    LAS float* WrgL = (LAS float*)(F.lds);
    LAS float* WreL = WrgL + 4096;
    LAS int* lcnt = (LAS int*)(F.lds + MOE_LCNT_OFF); LAS int* lbase = (LAS int*)(F.lds + MOE_LBASE_OFF); LAS unsigned* rec = (LAS unsigned*)(F.lds + MOE_REC_OFF);
    for (int k = F.tid; k < 1024; k += NWAVES * 64) {
        const int j = k >> 8, ln = (k & 255) >> 2, i = k & 3, slot = ((j * 4 + i) * 64 + ln) * 4;
        *(LAS f32x4*)(WrgL + slot) = *(const f32x4*)(A.wrg + (size_t)k * 4);
#pragma unroll
        for (int g = 0; g < 4; ++g) { const float* src = A.wre + ((size_t)g * 1024 + k) * 8;
            *(LAS f32x4*)(WreL + (g * 2 + 0) * 4096 + slot) = *(const f32x4*)src; *(LAS f32x4*)(WreL + (g * 2 + 1) * 4096 + slot) = *(const f32x4*)(src + 4); }
    }
    if (F.tid < 32) lcnt[F.tid] = 0;
    __syncthreads();
    f32x4 g4[4];
#pragma unroll
    for (int j = 0; j < 4; ++j) g4[j] = *(const f32x4*)(A.gffn + 4 * F.lane + 256 * j);
    const int tok0 = 64 * F.vcu + 8 * F.wave;
    for (int tt = 0; tt < 8; ++tt) {
        const int tok = tok0 + tt;
        const GAS f32x4* xr = (const GAS f32x4*)(A.h + (size_t)tok * D_MODEL) + F.lane;
        f32x4 v[4]; float ss = 0.f;
#pragma unroll
        for (int j = 0; j < 4; ++j) { v[j] = xr[64 * j]; ss += (v[j].x * v[j].x + v[j].y * v[j].y) + (v[j].z * v[j].z + v[j].w * v[j].w); }
        const float rs = 1.0f / sqrtf(wave_sum(ss) * (1.f / D_MODEL) + EPS);
        GAS unsigned long long* o8 = (GAS unsigned long long*)(A.HN + (size_t)tok * D_MODEL) + F.lane;
        f32x4 zg = (f32x4){0.f, 0.f, 0.f, 0.f};
#pragma unroll
        for (int j = 0; j < 4; ++j) {
            v[j] = v[j] * rs * g4[j];
            o8[64 * j] = (unsigned long long)pk2(v[j].x, v[j].y) | ((unsigned long long)pk2(v[j].z, v[j].w) << 32);
#pragma unroll
            for (int i = 0; i < 4; ++i) zg += v[j][i] * *(const LAS f32x4*)(WrgL + ((j * 4 + i) * 64 + F.lane) * 4);
        }
        float z[4];
#pragma unroll
        for (int g = 0; g < 4; ++g) z[g] = wave_sum(zg[g]) + A.brg[g];
        int gs = 0; float zm = z[0];
#pragma unroll
        for (int g = 1; g < 4; ++g) if (z[g] > zm) { zm = z[g]; gs = g; }
        float den = 0.f;
#pragma unroll
        for (int g = 0; g < 4; ++g) den += expf(z[g] - zm);
        const float pg_top = 1.0f / den;
        gs = __builtin_amdgcn_readfirstlane(gs);
        const LAS float* W0 = WreL + (gs * 2) * 4096; const LAS float* W1 = W0 + 4096;
        f32x4 ea = (f32x4){0.f, 0.f, 0.f, 0.f}, eb = ea;
#pragma unroll
        for (int j = 0; j < 4; ++j)
#pragma unroll
            for (int i = 0; i < 4; ++i) { const int slot = ((j * 4 + i) * 64 + F.lane) * 4; ea += v[j][i] * *(const LAS f32x4*)(W0 + slot); eb += v[j][i] * *(const LAS f32x4*)(W1 + slot); }
        float ze[8];
#pragma unroll
        for (int e = 0; e < 4; ++e) { ze[e] = wave_sum(ea[e]) + A.bre[gs * 8 + e]; ze[4 + e] = wave_sum(eb[e]) + A.bre[gs * 8 + 4 + e]; }
        int i1 = 0; float v1 = ze[0];
#pragma unroll
        for (int e = 1; e < 8; ++e) if (ze[e] > v1) { v1 = ze[e]; i1 = e; }
        int i2 = 0; float v2 = -INFINITY;
#pragma unroll
        for (int e = 0; e < 8; ++e) if (e != i1 && ze[e] > v2) { v2 = ze[e]; i2 = e; }
        const float e2 = expf(v2 - v1); const float g1 = pg_top / (1.0f + e2), g2 = pg_top * e2 / (1.0f + e2);
        if (F.lane == 0) {
            const int ea1 = gs * 8 + i1, ea2 = gs * 8 + i2;
            const int r1 = __hip_atomic_fetch_add(lcnt + ea1, 1, __ATOMIC_RELAXED, __HIP_MEMORY_SCOPE_WORKGROUP), r2 = __hip_atomic_fetch_add(lcnt + ea2, 1, __ATOMIC_RELAXED, __HIP_MEMORY_SCOPE_WORKGROUP);
            LAS unsigned* rc = rec + (8 * F.wave + tt) * 8;
            rc[0] = (unsigned)ea1; rc[1] = (unsigned)ea2; rc[2] = __float_as_uint(g1); rc[3] = __float_as_uint(g2); rc[4] = (unsigned)r1; rc[5] = (unsigned)r2;
        }
    }
    __syncthreads();
    if (F.tid < 32) { const int c = lcnt[F.tid]; lbase[F.tid] = c ? (int)__hip_atomic_fetch_add(A.gcount + F.tid, (unsigned)c, RLX_AGENT) : 0; }
    __syncthreads();
    if (F.tid < 64) {
        const LAS unsigned* rc = rec + F.tid * 8; const int tok = 64 * F.vcu + F.tid;
#pragma unroll
        for (int s = 0; s < 2; ++s) { const int e = (int)rc[s], idx = lbase[e] + (int)rc[4 + s];
            A.pair_tok[e * CAP + idx] = tok; A.pair_gate[e * CAP + idx] = __uint_as_float(rc[2 + s]); A.tok_pair[tok * 2 + s] = (e << 16) | idx; }
    }
}
__device__ __forceinline__ void moe_tables(Frame& F, gu32* gcount) {
    frame_refresh(F);
    LAS int* cnt = (LAS int*)(F.lds + MOE_CNT_OFF); LAS int* pt = (LAS int*)(F.lds + MOE_PT_OFF);
    if (F.tid < 64) {
        const int c = (F.lane < 32) ? (int)__hip_atomic_load(gcount + F.lane, RLX_AGENT) : 0;
        const int tl = (c + 255) >> 8; int inc = tl;
#pragma unroll
        for (int o = 1; o < 32; o <<= 1) { const int n = __shfl_up(inc, o); if (F.lane >= o) inc += n; }
        if (F.lane < 32) { cnt[F.lane] = c; pt[F.lane] = inc - tl; }
        if (F.lane == 31) pt[32] = inc;
    }
    __syncthreads();
}
namespace pg8 {
struct MoeUnit { int e, mt, pn, rows, crow0; };
struct MoeSched {
    typedef MoeUnit UnitT;
    const PG8_LAS int* cnt; const PG8_LAS int* pt; int G, c, nunits;
    __device__ __forceinline__ void init(const PG8_LAS int* cnt_, const PG8_LAS int* pt_, int G_, int c_) { cnt = cnt_; pt = pt_; G = G_; c = c_; nunits = pt_[32] * 4; }
    __device__ __forceinline__ bool next(int i, MoeUnit& u) const {
        const int L = i * G + c; if (L >= nunits) return false;
        int wgid = L; { const int q = nunits / NXCD, r = nunits % NXCD, xcd = wgid % NXCD, off = wgid / NXCD; wgid = (xcd < r ? xcd * (q + 1) : r * (q + 1) + (xcd - r) * q) + off; }
        const int mtg = wgid >> 2; u.pn = wgid & 3;
        int e = 0;
        for (int k = 16; k >= 1; k >>= 1) if (e + k < 32 && pt[e + k] <= mtg) e += k;
        while (e < 31 && pt[e + 1] <= mtg) ++e;
        u.e = e; u.mt = mtg - pt[e]; u.rows = min(256, cnt[e] - 256 * u.mt); u.crow0 = 256 * mtg;
        return true;
    }
};
struct SrcGU {
    const char* A; int K; const int* pair_tok; const char* Bt;
    __device__ __forceinline__ void a_offs(const MoeUnit& u, int R, int C, unsigned (&off)[2]) const {
#pragma unroll
        for (int h = 0; h < 2; ++h) { const int r = h * 128 + R; const int tok = (r < u.rows) ? pair_tok[u.e * CAP + 256 * u.mt + r] : 0; off[h] = (unsigned)(tok * K + C) * 2u; }
    }
    __device__ __forceinline__ const char* b_base(const MoeUnit& u) const { return Bt + ((size_t)u.e * 1024 + 256 * u.pn) * (size_t)K * 2; }
};
struct SrcDown {
    const char* A; int K; const char* Bt;
    __device__ __forceinline__ void a_offs(const MoeUnit& u, int R, int C, unsigned (&off)[2]) const {
#pragma unroll
        for (int h = 0; h < 2; ++h) off[h] = (unsigned)((u.crow0 + h * 128 + R) * K + C) * 2u;
    }
    __device__ __forceinline__ const char* b_base(const MoeUnit& u) const { return Bt + ((size_t)u.e * 1024 + 256 * u.pn) * (size_t)K * 2; }
};
struct EpiGU {
    static constexpr bool PERM = true;
    bf16_t* H;
    __device__ __forceinline__ void operator()(const f32x4 (&acc)[2][2][4][2], const MoeUnit& u, int wr, int wc, int fr_, int fq) const {
        int fr = fr_; asm volatile("" : "+v"(fr));
        const unsigned col0 = (unsigned)(u.pn * 128 + wc * 32 + 8 * fq);
#pragma unroll
        for (int ai = 0; ai < 2; ++ai)
#pragma unroll
            for (int m = 0; m < 4; ++m) { const unsigned r = (unsigned)(u.crow0 + ai * HALF + wr * 64 + m * 16 + fr); float hv[8];
#pragma unroll
                for (int n = 0; n < 2; ++n)
#pragma unroll
                    for (int i = 0; i < 4; ++i) { const float gt = acc[ai][0][m][n][i], up = acc[ai][1][m][n][i];
                        hv[4 * n + i] = gt * __builtin_amdgcn_rcpf(1.0f + __builtin_amdgcn_exp2f(-gt * LOG2E)) * up; }
                u32x4 w; w.x = cvt_pk_bf16(hv[0], hv[1]); w.y = cvt_pk_bf16(hv[2], hv[3]); w.z = cvt_pk_bf16(hv[4], hv[5]); w.w = cvt_pk_bf16(hv[6], hv[7]);
                *(u32x4*)(H + (r * (unsigned)D_EXP + col0)) = w; }
    }
};
struct EpiDown {
    static constexpr bool PERM = true;
    bf16_t* Y; const float* pair_gate;
    __device__ __forceinline__ void operator()(const f32x4 (&acc)[2][2][4][2], const MoeUnit& u, int wr, int wc, int fr_, int fq) const {
        int fr = fr_; asm volatile("" : "+v"(fr));
        const unsigned col0 = (unsigned)(u.pn * BM + wc * 32 + 8 * fq);
        const float* gp = pair_gate + (u.e * CAP + 256 * u.mt);
#pragma unroll
        for (int ai = 0; ai < 2; ++ai)
#pragma unroll
            for (int m = 0; m < 4; ++m) { const int rl = ai * HALF + wr * 64 + m * 16 + fr; const unsigned off = (unsigned)(u.crow0 + rl) * (unsigned)D_MODEL + col0;
                const float gt = (rl < u.rows) ? gp[rl] : 0.f;
#pragma unroll
                for (int bj = 0; bj < 2; ++bj) { const f32x4 v0 = acc[ai][bj][m][0] * gt, v1 = acc[ai][bj][m][1] * gt;
                    u32x4 w; w.x = cvt_pk_bf16(v0[0], v0[1]); w.y = cvt_pk_bf16(v0[2], v0[3]); w.z = cvt_pk_bf16(v1[0], v1[1]); w.w = cvt_pk_bf16(v1[2], v1[3]);
                    *(u32x4*)(Y + (off + (unsigned)(bj * HALF))) = w; } }
    }
};
}
struct P6Args { float* out; const bf16* Y; const int* tok_pair; };
__device__ __forceinline__ void p6_final(Frame& F, const P6Args& A) {
    frame_refresh(F);
    const LAS int* pt = (const LAS int*)(F.lds + MOE_PT_OFF);
    const int gw = F.vcu * NWAVES + F.wave, NGW = F.G * NWAVES;
    for (int m = gw; m < NT; m += NGW) {
        const int p1 = A.tok_pair[m * 2], p2 = A.tok_pair[m * 2 + 1];
        const size_t r1 = (size_t)(256 * pt[p1 >> 16] + (p1 & 0xffff)), r2 = (size_t)(256 * pt[p2 >> 16] + (p2 & 0xffff));
        GAS f32x4* orow = (GAS f32x4*)(A.out + (size_t)m * D_MODEL) + F.lane;
        const GAS unsigned long long* y1 = (const GAS unsigned long long*)(A.Y + r1 * D_MODEL) + F.lane; const GAS unsigned long long* y2 = (const GAS unsigned long long*)(A.Y + r2 * D_MODEL) + F.lane;
#pragma unroll
        for (int j = 0; j < 4; ++j) { f32x4 o = orow[64 * j]; const unsigned long long a = y1[64 * j], b = y2[64 * j];
            const unsigned a0 = (unsigned)a, a1 = (unsigned)(a >> 32), b0 = (unsigned)b, b1 = (unsigned)(b >> 32);
            o.x += bf_lo(a0) + bf_lo(b0); o.y += bf_hi(a0) + bf_hi(b0); o.z += bf_lo(a1) + bf_lo(b1); o.w += bf_hi(a1) + bf_hi(b1);
            orow[64 * j] = o; }
    }
}
struct Args { const float* in[19]; float* out; unsigned char* ws; };
__global__ void __launch_bounds__(NWAVES * 64, 2) mk_fwd(Args args) {
    extern __shared__ __attribute__((aligned(16))) unsigned char lds[];
    Frame F;
    F.lds = (LAS unsigned char*)lds;
    F.MISC = (volatile LAS unsigned*)(F.lds + MISC_OFF);
    F.tid = threadIdx.x; F.lane = F.tid & 63; F.wave = __builtin_amdgcn_readfirstlane(F.tid >> 6);
    F.G = gridDim.x; { const int bx = blockIdx.x; F.vcu = (F.G % 8 == 0) ? (bx % 8) * (F.G / 8) + bx / 8 : bx; }
    unsigned char* ws = args.ws;
    F.ctl = (gu32*)(ws + WS_CTL);
    for (int u = F.tid; u < (LDS_BYTES - LDSCTL_OFF) / 4; u += NWAVES * 64) ((LAS unsigned*)(F.lds + LDSCTL_OFF))[u] = 0u;
    __syncthreads();
    XcdBarrier bar = xcd_barrier_post((unsigned*)(F.ctl + CW_BAR), F.MISC + 8);

    {
        P0Args A{args.in[0], args.in[1], args.in[2], args.in[3], args.in[10], args.in[16], args.in[17], args.in[18],
                 (bf16*)(ws + WS_WIN), (bf16*)(ws + WS_WO), (bf16*)(ws + WS_WGU), (bf16*)(ws + WS_WD), (bf16*)(ws + WS_XN), (float*)(ws + WS_LOGF), (float*)(ws + WS_ROPE), (float*)(ws + WS_ROPE) + SEQ * 32,
                 args.in[4], args.in[5], args.in[6], args.in[7], (float*)(ws + WS_GTAB)};
        for (int rep = 0; rep < (REP == 1 ? 2 : 1); ++rep) p0_prologue(F, A);
    }
    xcd_barrier(bar);
    {
        pg8::Gemm g{(const pg8::bf16_t*)(ws + WS_XN), (const pg8::bf16_t*)(ws + WS_WIN), NT, NQKV, D_MODEL};
        pg8::StaticOrder S; S.init(NT, NQKV, F.G, (int)blockIdx.x);
        pg8::EpiQKV E{(pg8::bf16_t*)(ws + WS_QKV), (const float*)(ws + WS_GTAB), (const float*)(ws + WS_ROPE), (const float*)(ws + WS_ROPE) + SEQ * 32};
        for (int rep = 0; rep < (REP == 2 ? 2 : 1); ++rep) pg8::gemm_phase<pg8::EpiQKV, pg8::StaticOrder, true, true>(F.lds + RING_OFF, g, S, E);
    }
    xcd_barrier(bar);
    {
        P2Args A{(const bf16*)(ws + WS_QKV), (const float*)(ws + WS_LOGF), (bf16*)(ws + WS_A2), (bf16*)(ws + WS_DILP1), (bf16*)(ws + WS_DILP2), (float*)(ws + WS_LSE), (const float*)(ws + WS_GTAB)};
        p2_attention(F, A);
    }
    xcd_barrier(bar);
    {
        P25Args A{(bf16*)(ws + WS_A2), (const bf16*)(ws + WS_DILP1), (const bf16*)(ws + WS_DILP2), (const float*)(ws + WS_LSE), args.in[8], args.in[9]};
        p25_combine(F, A);
    }
    xcd_barrier(bar);
    {
        pg8::Gemm g{(const pg8::bf16_t*)(ws + WS_A2), (const pg8::bf16_t*)(ws + WS_WO), NT, D_MODEL, D_MODEL};
        pg8::StaticOrder S; S.init(NT, D_MODEL, F.G, (int)blockIdx.x);
        pg8::EpiRes E{args.in[0], args.out};
        for (int rep = 0; rep < (REP == 5 ? 2 : 1); ++rep) pg8::gemm_phase<pg8::EpiRes, pg8::StaticOrder, true, true>(F.lds + RING_OFF, g, S, E);
    }
    xcd_barrier(bar);
    {
        P35Args A{args.out, args.in[11], args.in[12], args.in[13], args.in[14], args.in[15], (bf16*)(ws + WS_HN), (int*)(ws + WS_PAIRTOK), (float*)(ws + WS_PAIRGATE), (int*)(ws + WS_TOKPAIR), F.ctl + CW_COUNT};
        p35_router(F, A);
    }
    xcd_barrier(bar);
    moe_tables(F, F.ctl + CW_COUNT);
    {
        pg8::MoeSched S; S.init((const LAS int*)(F.lds + MOE_CNT_OFF), (const LAS int*)(F.lds + MOE_PT_OFF), F.G, (int)blockIdx.x);
        pg8::SrcGU X{(const char*)(ws + WS_HN), D_MODEL, (const int*)(ws + WS_PAIRTOK), (const char*)(ws + WS_WGU)};
        pg8::EpiGU E{(pg8::bf16_t*)(ws + WS_HMID)};
        for (int rep = 0; rep < (REP == 6 ? 2 : 1); ++rep) pg8::gemm_phase2<pg8::EpiGU, pg8::MoeSched, pg8::SrcGU>(F.lds + RING_OFF, S, X, E);
    }
    xcd_barrier(bar);
    {
        pg8::MoeSched S; S.init((const LAS int*)(F.lds + MOE_CNT_OFF), (const LAS int*)(F.lds + MOE_PT_OFF), F.G, (int)blockIdx.x);
        pg8::SrcDown X{(const char*)(ws + WS_HMID), D_EXP, (const char*)(ws + WS_WD)};
        pg8::EpiDown E{(pg8::bf16_t*)(ws + WS_Y), (const float*)(ws + WS_PAIRGATE)};
        for (int rep = 0; rep < (REP == 7 ? 2 : 1); ++rep) pg8::gemm_phase2<pg8::EpiDown, pg8::MoeSched, pg8::SrcDown>(F.lds + RING_OFF, S, X, E);
    }
    xcd_barrier(bar);
    {
        P6Args A{args.out, (const bf16*)(ws + WS_Y), (const int*)(ws + WS_TOKPAIR)};
        p6_final(F, A);
    }
}
extern "C" void kernel_launch(void* const* d_in, const int* in_sizes, int n_in, void* d_out, int out_size, void* d_ws, size_t ws_size, hipStream_t stream) {
    static int grid = 0;
    if (grid == 0) {
        if (n_in != 19 || ws_size < WS_END) { fprintf(stderr, "kernel_launch: bad arguments (n_in %d, ws %zu)\n", n_in, ws_size); grid = -1; return; }
        int dev = 0, cus = 0;
        if (hipGetDevice(&dev) != hipSuccess || hipDeviceGetAttribute(&cus, hipDeviceAttributeMultiprocessorCount, dev) != hipSuccess) { grid = -1; return; }
        if (hipFuncSetAttribute((const void*)mk_fwd, hipFuncAttributeMaxDynamicSharedMemorySize, LDS_BYTES) != hipSuccess) { fprintf(stderr, "kernel_launch: hipFuncSetAttribute failed\n"); grid = -1; return; }
        int per_cu = 0;
        if (hipOccupancyMaxActiveBlocksPerMultiprocessor(&per_cu, (const void*)mk_fwd, NWAVES * 64, LDS_BYTES) != hipSuccess || per_cu < 1) fprintf(stderr, "kernel_launch: occupancy query says %d\n", per_cu);
        (void)hipGetLastError();
        grid = cus;
        if (grid != 256) { fprintf(stderr, "kernel_launch: this build needs 256 CUs (got %d)\n", cus); grid = -1; return; }
    }
    if (grid < 0) return;
    char* ws = (char*)d_ws; float* out = (float*)d_out;
    (void)hipMemsetAsync(ws + WS_CTL, 0, CTL_ZERO_BYTES, stream);
    Args a{};
    for (int i = 0; i < 19; ++i) a.in[i] = (const float*)d_in[i];
    a.out = out; a.ws = (unsigned char*)d_ws;
    hipLaunchKernelGGL(mk_fwd, dim3(grid), dim3(NWAVES * 64), LDS_BYTES, stream, a);
}
```

```cpp
#ifndef REP
#define REP 0
#endif
#ifndef DBGSEL
#define DBGSEL 0
#endif
#ifndef DBGK
#define DBGK 10.0f
#endif
#include <hip/hip_runtime.h>
#include <stdint.h>
#include <math.h>
#include <cstdio>

constexpr int D_MODEL = 1024, BATCH = 2, SEQ = 8192, NT = BATCH * SEQ;
constexpr int HD = 64, NH = 8, D_PROJ = 3080, NQKV = 3072;
constexpr int NE = 32, D_EXP = 512;
constexpr float EPS = 1e-6f;
constexpr float LOG2E = 1.4426950408889634f;
constexpr float QSCALE = 0.125f * LOG2E;

constexpr size_t MiB = 1u << 20, KiB = 1024;
constexpr size_t WS_CTL = 0, CTL_ZERO_BYTES = 128 * KiB;
constexpr size_t WS_GTAB = 256 * KiB;
constexpr size_t WS_LOGF = 512 * KiB;
constexpr size_t WS_ROPE = 1 * MiB;
constexpr size_t WS_CB = 3 * MiB;
constexpr size_t WS_ROUTE = 3 * MiB + 512 * KiB;
constexpr size_t WS_LSE = 4 * MiB + 512 * KiB;
constexpr size_t WS_WIN = 6 * MiB;
constexpr size_t WS_WO = 12 * MiB;
constexpr size_t WS_WGU = 14 * MiB;
constexpr size_t WS_WD = 78 * MiB;
constexpr size_t WS_XN = 110 * MiB;
constexpr size_t WS_QKV = 142 * MiB;
constexpr size_t QKV_TSTRIDE = (size_t)NT * 512;
constexpr size_t WS_A2 = 238 * MiB;
constexpr size_t WS_END = 270 * MiB;
namespace pg8 {
#define PG8_LAS __attribute__((address_space(3)))
typedef unsigned short bf16_t;
typedef short bf16x8 __attribute__((ext_vector_type(8)));
typedef float f32x4 __attribute__((ext_vector_type(4)));
typedef unsigned u32x4 __attribute__((ext_vector_type(4)));
constexpr int BM = 256, BK = 64, HALF = 128, HTB = HALF * BK * 2  , STAGE_BYTES = 8 * HTB, NXCD = 8, WGM = 8;

__host__ __device__ __forceinline__ int lds_byte(int r, int c) { const int st = (r >> 4) * 2 + (c >> 5), rr = r & 15, cc = c & 31, ob = rr * 64 + cc * 2; return st * 1024 + (ob ^ (((ob >> 9) & 1) << 5)); }
__host__ __device__ __forceinline__ void stage_rc(int b, int& R, int& C) { const int st = b / 1024, sb = b % 1024, swz = sb ^ (((sb >> 9) & 1) << 5); R = (st >> 1) * 16 + swz / 64; C = (st & 1) * 32 + (swz % 64) / 2; }
__host__ __device__ __forceinline__ int perm32(int rho) { const int n = rho >> 4, i = rho & 15; return 8 * (i >> 2) + 4 * n + (i & 3); }

struct Unit { int pm, pn; };
struct Gemm { const bf16_t* A; const bf16_t* Bt; int M, N, K; };

struct StaticOrder {
    int nM, nN, nwg, G, c;
    __host__ __device__ void init(int M, int N, int G_, int c_) { nM = M / BM; nN = N / BM; nwg = nM * nN; G = G_; c = c_; }
    __host__ __device__ bool next(int i, Unit& u) const {
        const long L = (long)i * G + c; if (L >= nwg) return false;
        int wgid = (int)L; { const int q = nwg / NXCD, r = nwg % NXCD, xcd = wgid % NXCD, off = wgid / NXCD; wgid = (xcd < r ? xcd * (q + 1) : r * (q + 1) + (xcd - r) * q) + off; }
        const int nig = WGM * nN, gid = wgid / nig, fm = gid * WGM, gsz = (nM - fm) < WGM ? (nM - fm) : WGM;
        u.pm = fm + ((wgid % nig) % gsz); u.pn = (wgid % nig) / gsz; return true;
    }
    __device__ __forceinline__ void a_ready(const Unit&) const {}
    __device__ __forceinline__ void done(const Unit&) const {}
};

__device__ __forceinline__ unsigned cvt_pk_bf16(float lo, float hi) { unsigned r; asm volatile("v_cvt_pk_bf16_f32 %0, %1, %2" : "=v"(r) : "v"(lo), "v"(hi)); return r; }

struct EpiQKV {
    static constexpr bool PERM = true, AFTER_DRAIN = false;
    bf16_t* qkv; const float* gtab; const float* cosT; const float* sinT;
    __device__ __forceinline__ void operator()(const f32x4 (&acc)[2][2][4][2], const Unit& u, int wr, int wc, int fr, int fq) const {
        const int tt = u.pn >> 1, head = (u.pn & 1) * 4 + wc;
        bf16_t* T = qkv + (size_t)tt * QKV_TSTRIDE + head * 64 + 8 * fq;
        const bool nrm = (tt != 2 && tt != 5), rope = (tt == 3 || tt == 4);
        f32x4 gv[2][2];
#pragma unroll
        for (int bj = 0; bj < 2; ++bj)
#pragma unroll
            for (int n = 0; n < 2; ++n) gv[bj][n] = (f32x4){1.f, 1.f, 1.f, 1.f};
        if (nrm) { const int gi = (tt == 0) ? 0 : (tt == 1) ? 1 : (tt == 3) ? 2 : 3; const float* g = gtab + gi * 64;
#pragma unroll
            for (int bj = 0; bj < 2; ++bj)
#pragma unroll
                for (int n = 0; n < 2; ++n) gv[bj][n] = *(const f32x4*)(g + 32 * bj + 8 * fq + 4 * n); }
#pragma unroll
        for (int ai = 0; ai < 2; ++ai)
#pragma unroll
            for (int m = 0; m < 4; ++m) {
                const int row = u.pm * BM + ai * HALF + wr * 64 + m * 16 + fr;
                f32x4 v[2][2];
#pragma unroll
                for (int bj = 0; bj < 2; ++bj)
#pragma unroll
                    for (int n = 0; n < 2; ++n) v[bj][n] = acc[ai][bj][m][n];
                if (nrm) {
                    float ss = 0.f;
#pragma unroll
                    for (int bj = 0; bj < 2; ++bj)
#pragma unroll
                        for (int n = 0; n < 2; ++n) { const f32x4 x = v[bj][n]; ss += (x[0] * x[0] + x[1] * x[1]) + (x[2] * x[2] + x[3] * x[3]); }
                    ss += __shfl_xor(ss, 16); ss += __shfl_xor(ss, 32);
                    const float rs = __builtin_amdgcn_rsqf(ss * (1.0f / 64.0f) + EPS);
#pragma unroll
                    for (int bj = 0; bj < 2; ++bj)
#pragma unroll
                        for (int n = 0; n < 2; ++n) v[bj][n] = v[bj][n] * rs * gv[bj][n];
                }
                if (rope) {
                    const int pos = row & (SEQ - 1);
#pragma unroll
                    for (int n = 0; n < 2; ++n) {
                        const f32x4 c = *(const f32x4*)(cosT + pos * 32 + 8 * fq + 4 * n), s = *(const f32x4*)(sinT + pos * 32 + 8 * fq + 4 * n);
                        const f32x4 x1 = v[0][n], x2 = v[1][n];
                        v[0][n] = x1 * c - x2 * s; v[1][n] = x2 * c + x1 * s;
                    }
                }
#pragma unroll
                for (int bj = 0; bj < 2; ++bj) { u32x4 w; w.x = cvt_pk_bf16(v[bj][0][0], v[bj][0][1]); w.y = cvt_pk_bf16(v[bj][0][2], v[bj][0][3]); w.z = cvt_pk_bf16(v[bj][1][0], v[bj][1][1]); w.w = cvt_pk_bf16(v[bj][1][2], v[bj][1][3]);
                    *(u32x4*)(T + (size_t)row * 512 + 32 * bj) = w; }
            }
    }
};
struct EpiRes {
    static constexpr bool PERM = false, AFTER_DRAIN = false;
    const float* X; float* out;
    __device__ __forceinline__ void operator()(const f32x4 (&acc)[2][2][4][2], const Unit& u, int wr, int wc, int fr, int fq) const {
        const int col0 = u.pn * BM + wc * 32 + 4 * fq;
#pragma unroll
        for (int ai = 0; ai < 2; ++ai)
#pragma unroll
            for (int m = 0; m < 4; ++m) { const size_t off = (size_t)(u.pm * BM + ai * HALF + wr * 64 + m * 16 + fr) * D_MODEL + col0;
#pragma unroll
                for (int bj = 0; bj < 2; ++bj)
#pragma unroll
                    for (int n = 0; n < 2; ++n) { const f32x4 xv = *(const f32x4*)(X + off + bj * HALF + n * 16); *(f32x4*)(out + off + bj * HALF + n * 16) = xv + acc[ai][bj][m][n]; } }
    }
};
template <class Epi, class Sched, bool ALIGN_EPI = false, bool SP2 = false>
__device__ __forceinline__ void gemm_phase(PG8_LAS unsigned char* lds, const Gemm g, const Sched& S, const Epi& E) {
    int tid_ = threadIdx.x; asm volatile("" : "+v"(tid_)); const int tid = tid_, wid = __builtin_amdgcn_readfirstlane(tid >> 6), lane = tid & 63, wr = wid >> 2, wc = wid & 3, fr = lane & 15, fq = lane >> 4;
    const int K = g.K, nt = K / BK;
    unsigned voffA[2], voffB[2];
#pragma unroll
    for (int i = 0; i < 2; ++i) { int R, C; stage_rc(tid * 16 + i * 8192, R, C); const int Rb = Epi::PERM ? ((R & ~31) + perm32(R & 31)) : R;
        voffA[i] = (unsigned)(R * K + C) * 2u; voffB[i] = (unsigned)(Rb * K + C) * 2u; }
    const size_t kstep = (size_t)(BK * 2);
    const size_t hstep = (size_t)HALF * K * 2;
    const size_t tstep = 2 * hstep;
    const unsigned ldsw = (unsigned)wid * 1024u;
    const int aoff = lds_byte(wr * 64 + fr, fq * 8), boff = lds_byte(wc * 32 + fr, fq * 8);
#define PG8_SA(b, h) (((b) * 2 + (h)) * HTB)
#define PG8_SB(b, h) ((4 + (b) * 2 + (h)) * HTB)
#define PG8_STAGE(bufoff, gbase, voff) do { _Pragma("unroll") for (int _i = 0; _i < 2; ++_i) \
        __builtin_amdgcn_global_load_lds((const unsigned*)((const char*)(gbase) + (voff)[_i]), (PG8_LAS unsigned*)(lds + (bufoff) + ldsw + _i * 8192), 16, 0, 0); } while (0)
#define PG8_LDA(dst, b, h) do { _Pragma("unroll") for (int m = 0; m < 4; ++m) _Pragma("unroll") for (int k = 0; k < 2; ++k) dst[m][k] = *(const PG8_LAS bf16x8*)(lds + PG8_SA(b, h) + aoff + m * 2048 + k * 1024); } while (0)
#define PG8_LDB(dst, b, h) do { _Pragma("unroll") for (int n = 0; n < 2; ++n) _Pragma("unroll") for (int k = 0; k < 2; ++k) dst[n][k] = *(const PG8_LAS bf16x8*)(lds + PG8_SB(b, h) + boff + n * 2048 + k * 1024); } while (0)
#define PG8_MMA(ai, bj, At, Bt) do { __builtin_amdgcn_s_setprio(1); _Pragma("unroll") for (int m = 0; m < 4; ++m) _Pragma("unroll") for (int n = 0; n < 2; ++n) _Pragma("unroll") for (int k = 0; k < 2; ++k) \
        acc[ai][bj][m][n] = __builtin_amdgcn_mfma_f32_16x16x32_bf16(Bt[n][k], At[m][k], acc[ai][bj][m][n], 0, 0, 0); __builtin_amdgcn_s_setprio(0); } while (0)
#define PG8_WAIT_V(n) asm volatile("s_waitcnt vmcnt(" #n ")" ::: "memory")
#define PG8_WAIT_L(n) asm volatile("s_waitcnt lgkmcnt(" #n ")" ::: "memory")
#define PG8_BAR __builtin_amdgcn_s_barrier()
#define PG8_SCHED __builtin_amdgcn_sched_barrier(0)
    Unit cur, nxt; int ui = 0;
    if (!S.next(0, cur)) return;
    f32x4 acc[2][2][4][2];
#pragma unroll
    for (int a = 0; a < 2; ++a)
#pragma unroll
        for (int b = 0; b < 2; ++b)
#pragma unroll
            for (int m = 0; m < 4; ++m)
#pragma unroll
                for (int n = 0; n < 2; ++n) acc[a][b][m][n] = (f32x4){0.f, 0.f, 0.f, 0.f};
    bf16x8 At[4][2], B0[2][2], B1[2][2];
    const char* cA = (const char*)g.A + (size_t)cur.pm * tstep; const char* cB = (const char*)g.Bt + (size_t)cur.pn * tstep;
    S.a_ready(cur);
    if constexpr (SP2) {
        PG8_STAGE(PG8_SB(0, 0), cB, voffB); PG8_STAGE(PG8_SB(0, 1), cB + hstep, voffB); PG8_STAGE(PG8_SA(0, 0), cA, voffA); PG8_STAGE(PG8_SA(0, 1), cA + hstep, voffA);
        if (wr == 1) PG8_BAR;
        PG8_WAIT_V(2); PG8_BAR;
        PG8_STAGE(PG8_SB(1, 0), cB + kstep, voffB); PG8_STAGE(PG8_SA(1, 0), cA + kstep, voffA); PG8_STAGE(PG8_SB(1, 1), cB + hstep + kstep, voffB);
        PG8_WAIT_V(6); PG8_BAR;
    } else {
        PG8_STAGE(PG8_SB(0, 0), cB, voffB); PG8_STAGE(PG8_SA(0, 0), cA, voffA); PG8_STAGE(PG8_SB(0, 1), cB + hstep, voffB); PG8_STAGE(PG8_SA(0, 1), cA + hstep, voffA);
        if (wr == 1) PG8_BAR;
        PG8_WAIT_V(4); PG8_BAR;
        PG8_STAGE(PG8_SB(1, 0), cB + kstep, voffB); PG8_STAGE(PG8_SA(1, 0), cA + kstep, voffA); PG8_STAGE(PG8_SB(1, 1), cB + hstep + kstep, voffB);
        PG8_WAIT_V(6); PG8_BAR;
    }
    for (;;) {
        const bool has_next = S.next(ui + 1, nxt);
        const char* nA = has_next ? (const char*)g.A + (size_t)nxt.pm * tstep : cA; const char* nB = has_next ? (const char*)g.Bt + (size_t)nxt.pn * tstep : cB;
        for (int t = 0; t < nt; t += 2) {
            const bool last = (t == nt - 2);
            const char* a1 = cA + (size_t)(t + 1) * kstep;
            const char* a2 = last ? nA : cA + (size_t)(t + 2) * kstep; const char* b2 = last ? nB : cB + (size_t)(t + 2) * kstep;
            const char* a3 = a2 + kstep; const char* b3 = b2 + kstep;
            if (last && has_next) S.a_ready(nxt);
            if constexpr (SP2) {
            PG8_LDB(B0, 0, 0); PG8_LDB(B1, 0, 1); PG8_SCHED; PG8_LDA(At, 0, 0); PG8_STAGE(PG8_SA(1, 1), a1 + hstep, voffA);
            PG8_WAIT_V(8); PG8_WAIT_L(0); PG8_BAR; PG8_MMA(0, 0, At, B0); PG8_MMA(0, 1, At, B1); PG8_BAR; PG8_SCHED;
            PG8_LDA(At, 0, 1); PG8_STAGE(PG8_SB(0, 0), b2, voffB); PG8_STAGE(PG8_SB(0, 1), b2 + hstep, voffB); PG8_STAGE(PG8_SA(0, 0), a2, voffA);
            PG8_WAIT_V(8); PG8_WAIT_L(0); PG8_BAR; PG8_MMA(1, 0, At, B0); PG8_MMA(1, 1, At, B1); PG8_BAR; PG8_SCHED;
            PG8_LDB(B0, 1, 0); PG8_LDB(B1, 1, 1); PG8_SCHED; PG8_LDA(At, 1, 0); PG8_STAGE(PG8_SA(0, 1), a2 + hstep, voffA);
            PG8_WAIT_V(8); PG8_WAIT_L(0); PG8_BAR; PG8_MMA(0, 0, At, B0); PG8_MMA(0, 1, At, B1); PG8_BAR; PG8_SCHED;
            PG8_LDA(At, 1, 1); PG8_STAGE(PG8_SB(1, 0), b3, voffB); PG8_STAGE(PG8_SB(1, 1), b3 + hstep, voffB); PG8_STAGE(PG8_SA(1, 0), a3, voffA);
            PG8_WAIT_V(8); PG8_WAIT_L(0); PG8_BAR; PG8_MMA(1, 0, At, B0); PG8_MMA(1, 1, At, B1); PG8_BAR; PG8_SCHED;
            } else {
            PG8_LDB(B0, 0, 0); PG8_SCHED; PG8_LDA(At, 0, 0); PG8_STAGE(PG8_SA(1, 1), a1 + hstep, voffA);
            PG8_WAIT_L(8); PG8_BAR; PG8_WAIT_L(0); PG8_MMA(0, 0, At, B0); PG8_BAR; PG8_SCHED;
            PG8_LDB(B1, 0, 1); PG8_STAGE(PG8_SB(0, 0), b2, voffB);
            PG8_BAR; PG8_WAIT_L(0); PG8_MMA(0, 1, At, B1); PG8_BAR;
            PG8_LDA(At, 0, 1); PG8_STAGE(PG8_SA(0, 0), a2, voffA);
            PG8_BAR; PG8_WAIT_L(0); PG8_MMA(1, 0, At, B0); PG8_BAR; PG8_SCHED;
            PG8_STAGE(PG8_SB(0, 1), b2 + hstep, voffB);
            PG8_WAIT_V(6); PG8_BAR; PG8_MMA(1, 1, At, B1); PG8_BAR;
            PG8_LDB(B0, 1, 0); PG8_SCHED; PG8_LDA(At, 1, 0); PG8_STAGE(PG8_SA(0, 1), a2 + hstep, voffA);
            PG8_WAIT_L(8); PG8_BAR; PG8_WAIT_L(0); PG8_MMA(0, 0, At, B0); PG8_BAR; PG8_SCHED;
            PG8_LDB(B1, 1, 1); PG8_STAGE(PG8_SB(1, 0), b3, voffB);
            PG8_BAR; PG8_WAIT_L(0); PG8_MMA(0, 1, At, B1); PG8_BAR;
            PG8_LDA(At, 1, 1); PG8_STAGE(PG8_SA(1, 0), a3, voffA);
            PG8_BAR; PG8_WAIT_L(0); PG8_MMA(1, 0, At, B0); PG8_BAR; PG8_SCHED;
            PG8_STAGE(PG8_SB(1, 1), b3 + hstep, voffB);
            PG8_WAIT_V(6); PG8_BAR; PG8_MMA(1, 1, At, B1); PG8_BAR;
            }
        }
        if constexpr (ALIGN_EPI) { if (wr == 0) PG8_BAR; }
        if constexpr (!Epi::AFTER_DRAIN) { E(acc, cur, wr, wc, fr, fq); S.done(cur); }
        if (!has_next) break;
#pragma unroll
        for (int a = 0; a < 2; ++a)
#pragma unroll
            for (int b = 0; b < 2; ++b)
#pragma unroll
                for (int m = 0; m < 4; ++m)
#pragma unroll
                    for (int n = 0; n < 2; ++n) acc[a][b][m][n] = (f32x4){0.f, 0.f, 0.f, 0.f};
        cur = nxt; cA = nA; cB = nB; ++ui;
        if constexpr (ALIGN_EPI) { if (wr == 1) PG8_BAR; }
    }
    PG8_WAIT_V(0);
    if constexpr (!ALIGN_EPI) { if (wr == 0) PG8_BAR; }
    PG8_BAR;
    if constexpr (Epi::AFTER_DRAIN) { E.fused(acc, cur, wr, wc, fr, fq, lds, wid, lane); S.done(cur); }
#undef PG8_SA
#undef PG8_SB
#undef PG8_STAGE
#undef PG8_LDA
#undef PG8_LDB
#undef PG8_MMA
#undef PG8_WAIT_V
#undef PG8_WAIT_L
#undef PG8_BAR
#undef PG8_SCHED
}
}
namespace pg8 {
template <class Epi, class Sched, class Src>
__device__ __forceinline__ void gemm_phase2(PG8_LAS unsigned char* lds, const Sched& S, const Src& X, const Epi& E) {
    typedef typename Sched::UnitT UnitT;
    int tid_ = threadIdx.x; asm volatile("" : "+v"(tid_)); const int tid = tid_, wid = __builtin_amdgcn_readfirstlane(tid >> 6), lane = tid & 63, wr = wid >> 2, wc = wid & 3, fr = lane & 15, fq = lane >> 4;
    const int K = X.K, nt = K / BK;
    int sR[2], sC[2]; unsigned voffB[2];
#pragma unroll
    for (int i = 0; i < 2; ++i) { int R, C; stage_rc(tid * 16 + i * 8192, R, C); const int Rb = Epi::PERM ? ((R & ~31) + perm32(R & 31)) : R; sR[i] = R; sC[i] = C; voffB[i] = (unsigned)(Rb * K + C) * 2u; }
    const size_t kstep = (size_t)(BK * 2);
    const size_t hstep = (size_t)HALF * K * 2;
    const unsigned ldsw = (unsigned)wid * 1024u;
    const int aoff = lds_byte(wr * 64 + fr, fq * 8), boff = lds_byte(wc * 32 + fr, fq * 8);
#define PG8_SA(b, h) (((b) * 2 + (h)) * HTB)
#define PG8_SB(b, h) ((4 + (b) * 2 + (h)) * HTB)
#define PG8_STAGE(bufoff, gbase, voff) do { _Pragma("unroll") for (int _i = 0; _i < 2; ++_i) \
        __builtin_amdgcn_global_load_lds((const unsigned*)((const char*)(gbase) + (voff)[_i]), (PG8_LAS unsigned*)(lds + (bufoff) + ldsw + _i * 8192), 16, 0, 0); } while (0)
#define PG8_LDA(dst, b, h) do { _Pragma("unroll") for (int m = 0; m < 4; ++m) _Pragma("unroll") for (int k = 0; k < 2; ++k) dst[m][k] = *(const PG8_LAS bf16x8*)(lds + PG8_SA(b, h) + aoff + m * 2048 + k * 1024); } while (0)
#define PG8_LDB(dst, b, h) do { _Pragma("unroll") for (int n = 0; n < 2; ++n) _Pragma("unroll") for (int k = 0; k < 2; ++k) dst[n][k] = *(const PG8_LAS bf16x8*)(lds + PG8_SB(b, h) + boff + n * 2048 + k * 1024); } while (0)
#define PG8_MMA(ai, bj, At, Bt) do { __builtin_amdgcn_s_setprio(1); _Pragma("unroll") for (int m = 0; m < 4; ++m) _Pragma("unroll") for (int n = 0; n < 2; ++n) _Pragma("unroll") for (int k = 0; k < 2; ++k) \
        acc[ai][bj][m][n] = __builtin_amdgcn_mfma_f32_16x16x32_bf16(Bt[n][k], At[m][k], acc[ai][bj][m][n], 0, 0, 0); __builtin_amdgcn_s_setprio(0); } while (0)
#define PG8_WAIT_V(n) asm volatile("s_waitcnt vmcnt(" #n ")" ::: "memory")
#define PG8_WAIT_L(n) asm volatile("s_waitcnt lgkmcnt(" #n ")" ::: "memory")
#define PG8_BAR __builtin_amdgcn_s_barrier()
#define PG8_SCHED __builtin_amdgcn_sched_barrier(0)
    UnitT cur, nxt; int ui = 0;
    if (!S.next(0, cur)) return;
    f32x4 acc[2][2][4][2];
#pragma unroll
    for (int a = 0; a < 2; ++a)
#pragma unroll
        for (int b = 0; b < 2; ++b)
#pragma unroll
            for (int m = 0; m < 4; ++m)
#pragma unroll
                for (int n = 0; n < 2; ++n) acc[a][b][m][n] = (f32x4){0.f, 0.f, 0.f, 0.f};
    bf16x8 At[4][2], B0[2][2], B1[2][2];
    unsigned oC0[2], oC1[2], oN0[2], oN1[2];
    { unsigned t2[2];
#pragma unroll
      for (int i = 0; i < 2; ++i) { X.a_offs(cur, sR[i], sC[i], t2); oC0[i] = t2[0]; oC1[i] = t2[1]; } }
    const char* const Ab = X.A;
    const char* cB = X.b_base(cur);
    PG8_STAGE(PG8_SB(0, 0), cB, voffB); PG8_STAGE(PG8_SB(0, 1), cB + hstep, voffB); PG8_STAGE(PG8_SA(0, 0), Ab, oC0); PG8_STAGE(PG8_SA(0, 1), Ab, oC1);
    if (wr == 1) PG8_BAR;
    PG8_WAIT_V(2); PG8_BAR;
    PG8_STAGE(PG8_SB(1, 0), cB + kstep, voffB); PG8_STAGE(PG8_SA(1, 0), Ab + kstep, oC0); PG8_STAGE(PG8_SB(1, 1), cB + hstep + kstep, voffB);
    PG8_WAIT_V(6); PG8_BAR;
    for (;;) {
        const bool has_next = S.next(ui + 1, nxt);
        const char* nB = cB;
#pragma unroll
        for (int i = 0; i < 2; ++i) { oN0[i] = oC0[i]; oN1[i] = oC1[i]; }
        if (has_next) { nB = X.b_base(nxt); unsigned t2[2];
#pragma unroll
            for (int i = 0; i < 2; ++i) { X.a_offs(nxt, sR[i], sC[i], t2); oN0[i] = t2[0]; oN1[i] = t2[1]; } }
        for (int t = 0; t < nt; t += 2) {
            const bool last = (t == nt - 2);
            const char* a1 = Ab + (size_t)(t + 1) * kstep;
            const char* a2 = last ? Ab : Ab + (size_t)(t + 2) * kstep; const char* b2 = last ? nB : cB + (size_t)(t + 2) * kstep;
            const char* a3 = a2 + kstep; const char* b3 = b2 + kstep;
            unsigned o20[2], o21[2];
#pragma unroll
            for (int i = 0; i < 2; ++i) { o20[i] = last ? oN0[i] : oC0[i]; o21[i] = last ? oN1[i] : oC1[i]; }
            PG8_LDB(B0, 0, 0); PG8_LDB(B1, 0, 1); PG8_SCHED; PG8_LDA(At, 0, 0); PG8_STAGE(PG8_SA(1, 1), a1, oC1);
            PG8_WAIT_V(8); PG8_WAIT_L(0); PG8_BAR; PG8_MMA(0, 0, At, B0); PG8_MMA(0, 1, At, B1); PG8_BAR; PG8_SCHED;
            PG8_LDA(At, 0, 1); PG8_STAGE(PG8_SB(0, 0), b2, voffB); PG8_STAGE(PG8_SB(0, 1), b2 + hstep, voffB); PG8_STAGE(PG8_SA(0, 0), a2, o20);
            PG8_WAIT_V(8); PG8_WAIT_L(0); PG8_BAR; PG8_MMA(1, 0, At, B0); PG8_MMA(1, 1, At, B1); PG8_BAR; PG8_SCHED;
            PG8_LDB(B0, 1, 0); PG8_LDB(B1, 1, 1); PG8_SCHED; PG8_LDA(At, 1, 0); PG8_STAGE(PG8_SA(0, 1), a2, o21);
            PG8_WAIT_V(8); PG8_WAIT_L(0); PG8_BAR; PG8_MMA(0, 0, At, B0); PG8_MMA(0, 1, At, B1); PG8_BAR; PG8_SCHED;
            PG8_LDA(At, 1, 1); PG8_STAGE(PG8_SB(1, 0), b3, voffB); PG8_STAGE(PG8_SB(1, 1), b3 + hstep, voffB); PG8_STAGE(PG8_SA(1, 0), a3, o20);
            PG8_WAIT_V(8); PG8_WAIT_L(0); PG8_BAR; PG8_MMA(1, 0, At, B0); PG8_MMA(1, 1, At, B1); PG8_BAR; PG8_SCHED;
        }
        if (wr == 0) PG8_BAR;
        E(acc, cur, wr, wc, fr, fq);
        if (!has_next) break;
#pragma unroll
        for (int a = 0; a < 2; ++a)
#pragma unroll
            for (int b = 0; b < 2; ++b)
#pragma unroll
                for (int m = 0; m < 4; ++m)
#pragma unroll
                    for (int n = 0; n < 2; ++n) acc[a][b][m][n] = (f32x4){0.f, 0.f, 0.f, 0.f};
        cur = nxt; cB = nB; ++ui;
#pragma unroll
        for (int i = 0; i < 2; ++i) { oC0[i] = oN0[i]; oC1[i] = oN1[i]; }
        if (wr == 1) PG8_BAR;
    }
    PG8_WAIT_V(0);
    PG8_BAR;
#undef PG8_SA
#undef PG8_SB
#undef PG8_STAGE
#undef PG8_LDA
#undef PG8_LDB
#undef PG8_MMA
#undef PG8_WAIT_V
#undef PG8_WAIT_L
#undef PG8_BAR
#undef PG8_SCHED
}
}
#define GAS __attribute__((address_space(1)))
#define LAS __attribute__((address_space(3)))
typedef unsigned short bf16;
typedef unsigned v4u __attribute__((ext_vector_type(4)));
typedef float f32x4 __attribute__((ext_vector_type(4)));
typedef short bf16x8 __attribute__((ext_vector_type(8)));
typedef GAS unsigned gu32;
typedef GAS unsigned long long gu64;
#define RLX_AGENT __ATOMIC_RELAXED, __HIP_MEMORY_SCOPE_AGENT
#define LDS_WAIT() asm volatile("s_waitcnt lgkmcnt(0)" ::: "memory")
#define VM_WAIT() asm volatile("s_waitcnt vmcnt(0)" ::: "memory")
__device__ __forceinline__ unsigned long long rt() { return __builtin_amdgcn_s_memrealtime(); }
__device__ __forceinline__ unsigned f2bf(float f) { unsigned u = __builtin_bit_cast(unsigned, f); return (u + 0x7fffu + ((u >> 16) & 1u)) >> 16; }
__device__ __forceinline__ unsigned pk2(float lo, float hi) { return f2bf(lo) | (f2bf(hi) << 16); }

#define XB_TMO      128
#define XB_XCNT(j)  (256  + 64 * (j))
#define XB_XSUB(j)  (1280 + 64 * (j))
#define XB_XGEN(j)  (2304 + 64 * (j))
#define XB_TOP      3328
#define XB_TOPGEN   3392
#define XCD_BAR_WORDS 3456
#define XB_SPIN_CAP (1u << 18)

__device__ __forceinline__ unsigned xb_ld(unsigned* p)              { return __hip_atomic_load(p, __ATOMIC_RELAXED, __HIP_MEMORY_SCOPE_AGENT); }
__device__ __forceinline__ unsigned xb_add(unsigned* p, unsigned v) { return __hip_atomic_fetch_add(p, v, __ATOMIC_RELAXED, __HIP_MEMORY_SCOPE_AGENT); }
__device__ __forceinline__ unsigned xb_xcc_id() { return (unsigned)__builtin_amdgcn_s_getreg((3 << 11) | 20) & 0xFu; }
#define XB_SPIN(cond, bar) do { unsigned _sp = 0; while (cond) { __builtin_amdgcn_s_sleep(1); \
    if ((++_sp & 255u) == 0u) { if (xb_ld(&(bar)[XB_TMO])) break; if (_sp > XB_SPIN_CAP) { atomicAdd(&(bar)[XB_TMO], 1u); break; } } } } while (0)

struct XcdBarrier {
    unsigned* bar; unsigned x;
    volatile LAS unsigned* st;
};

__device__ __forceinline__ XcdBarrier xcd_barrier_post(unsigned* bar, volatile LAS unsigned* st) {
    XcdBarrier b; b.bar = bar; b.x = xb_xcc_id(); b.st = st;
    if (threadIdx.x == 0) (void)xb_add(&bar[XB_XCNT(b.x)], 1u);
    return b;
}
__device__ __forceinline__ void xcd_barrier_complete(unsigned* bar, unsigned x, unsigned& nloc, unsigned& nx) {
    const unsigned G = gridDim.x * gridDim.y * gridDim.z;
    unsigned sum, cnt, mine, sp = 0u;
    for (;;) {
        sum = 0u; cnt = 0u; mine = 0u;
#pragma unroll
        for (unsigned j = 0; j < 16; ++j) { const unsigned c = xb_ld(&bar[XB_XCNT(j)]); sum += c; cnt += (c > 0u) ? 1u : 0u; mine = (j == x) ? c : mine; }
        if (sum == G) break;
        __builtin_amdgcn_s_sleep(1);
        if ((++sp & 255u) == 0u) { if (xb_ld(&bar[XB_TMO])) break; if (sp > XB_SPIN_CAP) { atomicAdd(&bar[XB_TMO], 1u); break; } }
    }
    nloc = mine > 0u ? mine : 1u; nx = cnt > 0u ? cnt : 1u;
}

__device__ __forceinline__ void xcd_barrier(const XcdBarrier& b) {
    asm volatile("s_waitcnt vmcnt(0)" ::: "memory");
    __syncthreads();
    if (threadIdx.x == 0) {
        unsigned* bar = b.bar;
        __builtin_amdgcn_s_waitcnt(0);
        unsigned nloc = b.st[0], nx = b.st[1];
        if (nloc == 0u) { xcd_barrier_complete(bar, b.x, nloc, nx); b.st[0] = nloc; b.st[1] = nx; }
        const unsigned old = xb_add(&bar[XB_XSUB(b.x)], 1u);
        const unsigned gen = old / nloc;
        if (old + 1u == (gen + 1u) * nloc) {
            __builtin_amdgcn_fence(__ATOMIC_RELEASE, "agent");
            asm volatile("s_waitcnt vmcnt(0)" ::: "memory");
            const unsigned og = xb_add(&bar[XB_TOP], 1u);
            const unsigned tg = og / nx;
            if (og + 1u == (tg + 1u) * nx) xb_add(&bar[XB_TOPGEN], 1u);
            else XB_SPIN(xb_ld(&bar[XB_TOPGEN]) == tg, bar);
            __builtin_amdgcn_fence(__ATOMIC_ACQUIRE, "agent");
            xb_add(&bar[XB_XGEN(b.x)], 1u);
            asm volatile("s_waitcnt vmcnt(0)" ::: "memory");
        } else {
            XB_SPIN(xb_ld(&bar[XB_XGEN(b.x)]) == gen, bar);
            __builtin_amdgcn_fence(__ATOMIC_ACQUIRE, "agent");
            asm volatile("s_waitcnt vmcnt(0)" ::: "memory");
        }
    }
    __syncthreads();
}
namespace att {
typedef short bf16x8 __attribute__((ext_vector_type(8)));
typedef float f32x16 __attribute__((ext_vector_type(16)));
typedef float f32x4 __attribute__((ext_vector_type(4)));
typedef unsigned u32x4 __attribute__((ext_vector_type(4)));
typedef short v4i16_t __attribute__((ext_vector_type(4)));
typedef short s16x4 __attribute__((ext_vector_type(4)));
#define ATT_LAS __attribute__((address_space(3)))
constexpr int SLOTB = 8192;
constexpr int KSLOT = SLOTB + 1024;
constexpr int L_K = 0, L_V = 2 * KSLOT, L_Z = L_V + 2 * SLOTB, L_WS = L_Z + 256, L_OST = L_WS + 8 * 256, L_CB = L_OST + 8 * 4096, L_BYTES = L_CB + 32768;
constexpr int D_K = 0, D_V = 6 * SLOTB, D_WS = 12 * SLOTB, D_OST = D_WS + 8 * 256, D_BYTES = D_OST + 8 * 4096;
__device__ __forceinline__ int crow(int r, int hi) { return (r & 3) + 8 * (r >> 2) + 4 * hi; }
__device__ __forceinline__ unsigned cvtpk(float lo, float hi) { unsigned r; asm volatile("v_cvt_pk_bf16_f32 %0, %1, %2" : "=v"(r) : "v"(lo), "v"(hi)); return r; }

struct Unit {
    const unsigned short* Q; const unsigned short* K; const unsigned short* V;
    int qrow0, qstride, krow0, kstride;
    int nt0, nt1;
    int ioff, W;
    ATT_LAS const float* bias;
    unsigned short* O; int opitch;
    float* lse;
};
struct State { float m, l; f32x16 o[2]; bf16x8 qx; f32x16 negm; };
__device__ __forceinline__ float max3f(float a, float b, float c) { return __builtin_fmaxf(__builtin_fmaxf(a, b), c); }
constexpr float THR = 8.0f;

#define ATT_SB() __builtin_amdgcn_sched_barrier(0)
__device__ __forceinline__ float xhalf_max(float v) { auto rr = __builtin_amdgcn_permlane32_swap(__float_as_uint(v), __float_as_uint(v), false, false); return __builtin_fmaxf(__uint_as_float(rr[0]), __uint_as_float(rr[1])); }
__device__ __forceinline__ s16x4 vtr(ATT_LAS const unsigned char* p) { return __builtin_bit_cast(s16x4, __builtin_amdgcn_ds_read_tr16_b64_v4i16((ATT_LAS v4i16_t*)p)); }
template <bool FOX>
__device__ __forceinline__ void tile_step(State& S, const bf16x8 (&qr)[4], ATT_LAS const unsigned char* Kt, ATT_LAS const unsigned char* Vt, ATT_LAS const unsigned char* Zt, ATT_LAS float* wsf, const Unit& U, int t, int lo_i, int lane) {
    const int r32 = lane & 31, hi = lane >> 5;
    ATT_LAS const unsigned char* Kb = Kt + r32 * 128; const int ksw = (r32 >> 1) & 7;
    ATT_LAS const unsigned char* Vb = Vt + ((lane >> 4) & 1) * 32 + (lane & 3) * 8 + (4 * hi + ((lane & 15) >> 2)) * 64;
    ATT_SB();
    bf16x8 kf[8], kx0, kx1;
    if (FOX) { ATT_LAS const unsigned char* Kx = hi ? Zt : (Kt + 8192 + r32 * 16); kx0 = *(ATT_LAS const bf16x8*)Kx; kx1 = *(ATT_LAS const bf16x8*)(Kx + (hi ? 0 : 512)); }
#pragma unroll
    for (int d0 = 0; d0 < 4; ++d0) { ATT_LAS const unsigned char* kp = Kb + (((2 * d0 + hi) ^ ksw) << 4); kf[2 * d0] = *(ATT_LAS const bf16x8*)kp; kf[2 * d0 + 1] = *(ATT_LAS const bf16x8*)(kp + 4096); }
    ATT_SB();
    f32x16 p0, p1;
    if (FOX) {
        f32x16 z;
#pragma unroll
        for (int r = 0; r < 16; ++r) z[r] = 0.f;
        p0 = __builtin_amdgcn_mfma_f32_32x32x16_bf16(kx0, S.qx, z, 0, 0, 0);
        p1 = __builtin_amdgcn_mfma_f32_32x32x16_bf16(kx1, S.qx, z, 0, 0, 0);
    } else { p0 = S.negm; p1 = S.negm; }
#pragma unroll
    for (int d0 = 0; d0 < 4; ++d0) {
        p0 = __builtin_amdgcn_mfma_f32_32x32x16_bf16(kf[2 * d0], qr[d0], p0, 0, 0, 0);
        p1 = __builtin_amdgcn_mfma_f32_32x32x16_bf16(kf[2 * d0 + 1], qr[d0], p1, 0, 0, 0);
    }
    ATT_SB();
    s16x4 va[8];
#pragma unroll
    for (int ks = 0; ks < 4; ++ks) { va[2 * ks] = vtr(Vb + ks * 1024); va[2 * ks + 1] = vtr(Vb + ks * 1024 + 512); }
    ATT_SB();
    const bool full = (lo_i - (64 * t + 63) >= 0) && (FOX || (lo_i + 31 - 64 * t <= U.W));
    if (!full) {
        const int dl = lo_i + r32 - 64 * t - 4 * hi;
#pragma unroll
        for (int r = 0; r < 16; ++r) { const int d0v = dl - ((r & 3) + 8 * (r >> 2)), d1v = d0v - 32;
            if (d0v < 0 || (!FOX && d0v > U.W)) p0[r] = -INFINITY;
            if (d1v < 0 || (!FOX && d1v > U.W)) p1[r] = -INFINITY; }
    }
    float tm = max3f(p0[0], p0[1], p1[0]);
    tm = max3f(tm, p1[1], p0[2]);
#pragma unroll
    for (int r = 2; r < 15; r += 2) { tm = max3f(tm, p0[r + 1], p1[r]); tm = max3f(tm, p1[r + 1], (r + 2 < 16) ? p0[r + 2] : p0[15]); }
    tm = xhalf_max(tm);
    if (__builtin_expect(__any(tm > THR), 0)) {
        const float dlt = fmaxf(tm, 0.f);
        const float mnew = __uint_as_float(cvtpk(S.m + dlt, 0.f) << 16);
        const float de = mnew - S.m; S.m = mnew;
#pragma unroll
        for (int r = 0; r < 16; ++r) { p0[r] -= de; p1[r] -= de; }
        const float f = __builtin_amdgcn_exp2f(-de);
        S.l *= f;
        if (hi == 0) wsf[r32] = f;
        if (FOX) { const unsigned w1 = cvtpk(-mnew, 0.f); S.qx = hi ? S.qx : __builtin_bit_cast(bf16x8, (u32x4){0x3f803f80u, w1, 0u, 0u}); }
        else {
#pragma unroll
            for (int r = 0; r < 16; ++r) S.negm[r] = -mnew; }
#pragma unroll
        for (int g = 0; g < 4; ++g) { const f32x4 a4 = *(ATT_LAS const f32x4*)(wsf + 8 * g + 4 * hi);
#pragma unroll
            for (int i = 0; i < 4; ++i) { S.o[0][4 * g + i] *= a4[i]; S.o[1][4 * g + i] *= a4[i]; } }
    }
    float ls = 0.f;
#pragma unroll
    for (int r = 0; r < 16; ++r) { p0[r] = __builtin_amdgcn_exp2f(p0[r]); p1[r] = __builtin_amdgcn_exp2f(p1[r]); ls += p0[r] + p1[r]; }
    S.l += ls;
    u32x4 pw[4];
#pragma unroll
    for (int i = 0; i < 4; ++i) { pw[0][i] = cvtpk(p0[2 * i], p0[2 * i + 1]); pw[1][i] = cvtpk(p0[8 + 2 * i], p0[9 + 2 * i]); pw[2][i] = cvtpk(p1[2 * i], p1[2 * i + 1]); pw[3][i] = cvtpk(p1[8 + 2 * i], p1[9 + 2 * i]); }
    ATT_SB();
    s16x4 vb[8];
#pragma unroll
    for (int ks = 0; ks < 4; ++ks) { vb[2 * ks] = vtr(Vb + 4096 + ks * 1024); vb[2 * ks + 1] = vtr(Vb + 4096 + ks * 1024 + 512); }
    ATT_SB();
#pragma unroll
    for (int ks = 0; ks < 4; ++ks) { const bf16x8 vf = (bf16x8){va[2 * ks][0], va[2 * ks][1], va[2 * ks][2], va[2 * ks][3], va[2 * ks + 1][0], va[2 * ks + 1][1], va[2 * ks + 1][2], va[2 * ks + 1][3]};
        S.o[0] = __builtin_amdgcn_mfma_f32_32x32x16_bf16(__builtin_bit_cast(bf16x8, pw[ks]), vf, S.o[0], 0, 0, 0); }
    ATT_SB();
#pragma unroll
    for (int ks = 0; ks < 4; ++ks) { const bf16x8 vf = (bf16x8){vb[2 * ks][0], vb[2 * ks][1], vb[2 * ks][2], vb[2 * ks][3], vb[2 * ks + 1][0], vb[2 * ks + 1][1], vb[2 * ks + 1][2], vb[2 * ks + 1][3]};
        S.o[1] = __builtin_amdgcn_mfma_f32_32x32x16_bf16(__builtin_bit_cast(bf16x8, pw[ks]), vf, S.o[1], 0, 0, 0); }
    ATT_SB();
}
__device__ __forceinline__ void state_init(State& S, int lane) {
    S.m = 0.f; S.l = 0.f;
#pragma unroll
    for (int r = 0; r < 16; ++r) { S.o[0][r] = 0.f; S.o[1][r] = 0.f; S.negm[r] = 0.f; }
    S.qx = (lane >> 5) ? __builtin_bit_cast(bf16x8, (u32x4){0u, 0u, 0u, 0u}) : __builtin_bit_cast(bf16x8, (u32x4){0x3f803f80u, 0u, 0u, 0u});
}
template <bool FOX>
__device__ __forceinline__ void unit_epilogue(State& S, ATT_LAS float* wsf, ATT_LAS unsigned short* stg, const Unit& U, int wid, int lane) {
    const int r32 = lane & 31, hi = lane >> 5;
    float L; { auto rr = __builtin_amdgcn_permlane32_swap(__float_as_uint(S.l), __float_as_uint(S.l), false, false); L = __uint_as_float(rr[0]) + __uint_as_float(rr[1]); }
    if (hi == 0) wsf[r32] = L;
    if (!FOX) { if (hi == 0) U.lse[(size_t)(U.qrow0 + U.qstride * (32 * wid + r32)) * 8] = S.m + __builtin_amdgcn_logf(L); }
    float rli[16];
#pragma unroll
    for (int g = 0; g < 4; ++g) { const f32x4 a4 = *(ATT_LAS const f32x4*)(wsf + 8 * g + 4 * hi);
#pragma unroll
        for (int i = 0; i < 4; ++i) rli[4 * g + i] = __builtin_amdgcn_rcpf(a4[i]); }
#pragma unroll
    for (int r = 0; r < 16; ++r) { const int orow = crow(r, hi);
#pragma unroll
        for (int d0 = 0; d0 < 2; ++d0) stg[orow * 64 + d0 * 32 + r32] = (unsigned short)(cvtpk(S.o[d0][r] * rli[r], 0.f) & 0xffffu); }
#pragma unroll
    for (int i = 0; i < 4; ++i) { const int row = i * 8 + (lane >> 3), ch = lane & 7; const u32x4 v = *(ATT_LAS const u32x4*)(stg + row * 64 + ch * 8);
        *(u32x4*)(U.O + (size_t)(U.qrow0 + U.qstride * (32 * wid + row)) * U.opitch + ch * 8) = v; }
}
__device__ __forceinline__ void load_q(bf16x8 (&qr)[4], const Unit& U, int wid, int lane) {
    const unsigned short* qp = U.Q + (size_t)(U.qrow0 + U.qstride * (32 * wid + (lane & 31))) * 512 + (lane >> 5) * 8;
#pragma unroll
    for (int d0 = 0; d0 < 4; ++d0) qr[d0] = *(const bf16x8*)(qp + d0 * 16);
}

__device__ __forceinline__ void fox_unit(const Unit& U, ATT_LAS unsigned char* lds, unsigned long long (&dbg)[4], int pulled, ATT_LAS int* qslot) {
    int tid_ = threadIdx.x; asm volatile("" : "+v"(tid_)); const int tid = tid_, lane = tid & 63; const int wid = __builtin_amdgcn_readfirstlane(tid >> 6);
    bf16x8 qr[4]; load_q(qr, U, wid, lane);
    const int lo_i = 32 * wid + U.ioff;
    const int wt1 = min(U.nt1, ((lo_i + 31) >> 6) + 1);
    State S; state_init(S, lane);
    const int prow = 8 * wid + (lane >> 3), pch = lane & 7;
    const unsigned short* kbase = U.K + pch * 8;
    const unsigned short* vbase = U.V + pch * 8;
    ATT_LAS unsigned char* kdst = lds + L_K + prow * 128 + ((pch ^ ((prow >> 1) & 7)) << 4);
    ATT_LAS unsigned char* vdst = lds + L_V + (pch >> 2) * 4096 + prow * 64 + (pch & 3) * 16;
    ATT_LAS unsigned char* xdst = lds + L_K + 8192 + lane * 16;
    ATT_LAS float* wsf = (ATT_LAS float*)(lds + L_WS) + wid * 64;
    const float cbref = U.bias[U.ioff];
    if (tid < 4) ((ATT_LAS unsigned*)(lds + L_Z))[tid] = 0u;
    u32x4 kA, vA, kB, vB;
#define ATT_LOAD(kr, vr, t) do { const size_t ro_ = (size_t)(U.krow0 + U.kstride * (64 * (t) + prow)) * 512; kr = *(const u32x4*)(kbase + ro_); vr = *(const u32x4*)(vbase + ro_); } while (0)
#define ATT_WRITE(kr, vr, slot, t) do { *(ATT_LAS u32x4*)(kdst + (slot) * KSLOT) = kr; *(ATT_LAS u32x4*)(vdst + (slot) * SLOTB) = vr; \
        if (wid == 0) { const float bb = U.bias[64 * (t) + lane] - cbref; const unsigned bh = cvtpk(bb, 0.f) & 0xffffu; const float br = bb - __uint_as_float(bh << 16); \
                        *(ATT_LAS u32x4*)(xdst + (slot) * KSLOT) = (u32x4){bh | (cvtpk(br, 0.f) << 16), 0x3f80u, 0u, 0u}; } } while (0)
    const int tl = U.nt1 - 1;
    ATT_LOAD(kA, vA, U.nt0); ATT_LOAD(kB, vB, min(U.nt0 + 1, tl));
    ATT_WRITE(kA, vA, 0, U.nt0);
    __syncthreads();
#define ATT_STEP(kCur, vCur, kNxt, vNxt, s) do { const int t_ = U.nt0 + (s); \
        unsigned long long c0_ = 0, c1_ = 0, c2_ = 0; if (DBGSEL) c0_ = __builtin_amdgcn_s_memrealtime(); \
        ATT_LOAD(kCur, vCur, min(t_ + 2, tl)); \
        if (t_ < wt1) tile_step<true>(S, qr, lds + L_K + ((s) & 1) * KSLOT, lds + L_V + ((s) & 1) * SLOTB, lds + L_Z, wsf, U, t_, lo_i, lane); \
        if (DBGSEL) c1_ = __builtin_amdgcn_s_memrealtime(); \
        ATT_WRITE(kNxt, vNxt, ((s) & 1) ^ 1, min(t_ + 1, tl)); \
        if (DBGSEL) c2_ = __builtin_amdgcn_s_memrealtime(); \
        __syncthreads(); \
        if (DBGSEL) { const unsigned long long c3_ = __builtin_amdgcn_s_memrealtime(); dbg[0] += c1_ - c0_; dbg[1] += c2_ - c1_; dbg[2] += c3_ - c2_; dbg[3] += 1; } } while (0)
    const int nsteps = U.nt1 - U.nt0;
    int s_ = 0;
    for (; s_ + 1 < nsteps; s_ += 2) { ATT_STEP(kA, vA, kB, vB, s_); ATT_STEP(kB, vB, kA, vA, s_ + 1); }
    if (s_ < nsteps) ATT_STEP(kA, vA, kB, vB, s_);
#undef ATT_STEP
#undef ATT_LOAD
#undef ATT_WRITE
    unit_epilogue<true>(S, wsf, (ATT_LAS unsigned short*)(lds + L_OST) + wid * 2048, U, wid, lane);
    if (tid == 0) *qslot = pulled;
    __syncthreads();
}

struct Pre { u32x4 k[6], v[6]; };
__device__ __forceinline__ void dil_prefetch(Pre& P, const Unit& U) {
    int tid_ = threadIdx.x; asm volatile("" : "+v"(tid_)); const int tid = tid_, lane = tid & 63; const int wid = __builtin_amdgcn_readfirstlane(tid >> 6);
    const int prow = 8 * wid + (lane >> 3), pch = lane & 7;
#pragma unroll
    for (int j = 0; j < 6; ++j) if (j >= U.nt0) { const size_t ro = (size_t)(U.krow0 + U.kstride * (64 * j + prow)) * 512 + pch * 8;
        P.k[j] = *(const u32x4*)(U.K + ro); P.v[j] = *(const u32x4*)(U.V + ro); }
}
__device__ __forceinline__ void dil_stage(const Pre& P, const Unit& U, ATT_LAS unsigned char* lds) {
    int tid_ = threadIdx.x; asm volatile("" : "+v"(tid_)); const int tid = tid_, lane = tid & 63; const int wid = __builtin_amdgcn_readfirstlane(tid >> 6);
    const int prow = 8 * wid + (lane >> 3), pch = lane & 7;
    ATT_LAS unsigned char* kdst = lds + D_K + prow * 128 + ((pch ^ ((prow >> 1) & 7)) << 4);
    ATT_LAS unsigned char* vdst = lds + D_V + (pch >> 2) * 4096 + prow * 64 + (pch & 3) * 16;
#pragma unroll
    for (int j = 0; j < 6; ++j) if (j >= U.nt0) { *(ATT_LAS u32x4*)(kdst + j * SLOTB) = P.k[j]; *(ATT_LAS u32x4*)(vdst + j * SLOTB) = P.v[j]; }
}
__device__ __forceinline__ void dil_compute(const Unit& U, ATT_LAS unsigned char* lds) {
    int tid_ = threadIdx.x; asm volatile("" : "+v"(tid_)); const int tid = tid_, lane = tid & 63; const int wid = __builtin_amdgcn_readfirstlane(tid >> 6);
    bf16x8 qr[4]; load_q(qr, U, wid, lane);
    const int lo_i = 32 * wid + U.ioff;
    const int wt0 = max(U.nt0, (lo_i - U.W) >> 6), wt1 = min(U.nt1, ((lo_i + 31) >> 6) + 1);
    State S; state_init(S, lane);
    ATT_LAS float* wsf = (ATT_LAS float*)(lds + D_WS) + wid * 64;
    for (int t = wt0; t < wt1; ++t) tile_step<false>(S, qr, lds + D_K + t * SLOTB, lds + D_V + t * SLOTB, lds, wsf, U, t, lo_i, lane);
    unit_epilogue<false>(S, wsf, (ATT_LAS unsigned short*)(lds + D_OST) + wid * 2048, U, wid, lane);
}
#undef ATT_LAS
}
constexpr int NWAVES = 8;
constexpr int RING_OFF = 0, RING_BYTES = 131072;
constexpr int LDSCTL_OFF = 147456, MISC_OFF = LDSCTL_OFF + 320;
constexpr int QS_OFF = MISC_OFF + 128;
constexpr int STAMP_OFF = LDSCTL_OFF + 8192;
constexpr int LDS_BYTES = 163840;
constexpr int CW_TMO = 0, CW_CODE = 1;
constexpr int CW_BAR = 4096;
constexpr int CW_COUNT = 8192;
constexpr int CW_QUEUE = 8448;
static_assert((CW_BAR + XCD_BAR_WORDS) * 4 <= (int)CTL_ZERO_BYTES && (CW_QUEUE + 32 * 64) * 4 <= (int)CTL_ZERO_BYTES, "CTL words inside the memset region");

struct Frame {
    LAS unsigned char* lds;
    volatile LAS unsigned* MISC;
    gu32* ctl;
    int tid, lane, wave;
    int vcu, G;
};
__device__ __forceinline__ void frame_refresh(Frame& F) { int t = threadIdx.x; asm volatile("" : "+v"(t)); F.tid = t; F.lane = t & 63; F.wave = __builtin_amdgcn_readfirstlane(t >> 6); }
__device__ __forceinline__ float wave_sum(float v) {
#pragma unroll
    for (int o = 1; o < 64; o <<= 1) v += __shfl_xor(v, o);
    return v;
}
__device__ __forceinline__ float wave_max(float v) {
#pragma unroll
    for (int o = 1; o < 64; o <<= 1) v = fmaxf(v, __shfl_xor(v, o));
    return v;
}

struct MapIdent { int off; __device__ __forceinline__ int operator()(int n) const { return off + n; } };
struct MapWin { __device__ __forceinline__ int operator()(int c) const { const int tile = c >> 8, l = c & 255; return tile * 256 + 128 * ((l >> 5) & 1) + 32 * (l >> 6) + (l & 31); } };
struct MapGU { int base; __device__ __forceinline__ int operator()(int c) const { return base + (c >> 7) * 256 + (c & 127); } };
template <class RowMap>
__device__ __forceinline__ void p0_tile(const float* W, int K, int ldw, int nblk, bf16* WT, const RowMap& rm, LAS float* scr, int item, int lane) {
    const int kb = item / nblk, nb = item % nblk, k0 = 64 * kb, n0 = 64 * nb;
    f32x4 v[16];
    const float* src = W + (size_t)(k0 + (lane >> 4)) * ldw + n0 + 4 * (lane & 15);
#pragma unroll
    for (int i = 0; i < 16; ++i) v[i] = __builtin_nontemporal_load((const f32x4*)(src + (size_t)(4 * i) * ldw));
#pragma unroll
    for (int i = 0; i < 16; ++i) { LAS float* d = scr + (4 * i + (lane >> 4)) * 65 + 4 * (lane & 15); d[0] = v[i].x; d[1] = v[i].y; d[2] = v[i].z; d[3] = v[i].w; }
    LDS_WAIT(); asm volatile("" ::: "memory");
    const int c = lane & 7;
#pragma unroll
    for (int j = 0; j < 8; ++j) { const int n = (lane >> 3) + 8 * j; const LAS float* s = scr + (8 * c) * 65 + n;
        v4u o; o.x = pk2(s[0 * 65], s[1 * 65]); o.y = pk2(s[2 * 65], s[3 * 65]); o.z = pk2(s[4 * 65], s[5 * 65]); o.w = pk2(s[6 * 65], s[7 * 65]);
        *(GAS v4u*)(WT + (size_t)rm(n0 + n) * K + k0 + 8 * c) = o; }
    LDS_WAIT(); asm volatile("" ::: "memory");
}

struct P0Args { const float* x; const float* norm_mix; const float* w_in; const float* b_forget; const float* w_out; const float* w_gate; const float* w_up; const float* w_down;
                bf16* Win_t; bf16* Wo_t; bf16* Wgu_t; bf16* Wd_t; bf16* XN; float* logf; float* cosT; float* sinT; const float* g0; const float* g1; const float* g2; const float* g3; float* gtab; };

__device__ __forceinline__ void p0_prologue(Frame& F, const P0Args& A) {
    frame_refresh(F);
    const int gw = F.vcu * NWAVES + F.wave, NGW = F.G * NWAVES;
    {
        LAS float* slab = (LAS float*)(F.lds + RING_OFF);
        for (int k = F.tid; k < 1024; k += NWAVES * 64) {
            const f32x4 a = *(const f32x4*)(A.w_in + (size_t)k * D_PROJ + 3072), b = *(const f32x4*)(A.w_in + (size_t)k * D_PROJ + 3076);
            const int j = k >> 8, ln = (k & 255) >> 2, i = k & 3; LAS float* d = slab + (size_t)(((j * 4 + i) * 64 + ln) * 8);
            *(LAS f32x4*)d = a; *(LAS f32x4*)(d + 4) = b;
        }
        __syncthreads();
        f32x4 g4[4];
#pragma unroll
        for (int j = 0; j < 4; ++j) g4[j] = *(const f32x4*)(A.norm_mix + 4 * F.lane + 256 * j);
        for (int rep = 0; rep < (REP == 8 ? 2 : 1); ++rep)
        for (int m = gw; m < NT; m += NGW) {
            const GAS f32x4* xr = (const GAS f32x4*)(A.x + (size_t)m * D_MODEL) + F.lane;
            f32x4 v[4]; float ss = 0.f;
#pragma unroll
            for (int j = 0; j < 4; ++j) { v[j] = __builtin_nontemporal_load(xr + 64 * j); ss += (v[j].x * v[j].x + v[j].y * v[j].y) + (v[j].z * v[j].z + v[j].w * v[j].w); }
            const float rs = 1.0f / sqrtf(wave_sum(ss) * (1.f / D_MODEL) + EPS);
            float fa[8];
#pragma unroll
            for (int c = 0; c < 8; ++c) fa[c] = 0.f;
            GAS unsigned long long* o8 = (GAS unsigned long long*)(A.XN + (size_t)m * D_MODEL) + F.lane;
#pragma unroll
            for (int j = 0; j < 4; ++j) {
                v[j] = v[j] * rs * g4[j];
                o8[64 * j] = (unsigned long long)pk2(v[j].x, v[j].y) | ((unsigned long long)pk2(v[j].z, v[j].w) << 32);
#pragma unroll
                for (int i = 0; i < 4; ++i) { const LAS float* d = slab + (size_t)(((j * 4 + i) * 64 + F.lane) * 8); const f32x4 w0 = *(const LAS f32x4*)d, w1 = *(const LAS f32x4*)(d + 4); const float xv = v[j][i];
                    fa[0] += xv * w0.x; fa[1] += xv * w0.y; fa[2] += xv * w0.z; fa[3] += xv * w0.w; fa[4] += xv * w1.x; fa[5] += xv * w1.y; fa[6] += xv * w1.z; fa[7] += xv * w1.w; }
            }
#pragma unroll
            for (int c = 0; c < 8; ++c) fa[c] = wave_sum(fa[c]);
            if (F.lane < 8) { float z = fa[0];
#pragma unroll
                for (int c = 1; c < 8; ++c) z = (F.lane == c) ? fa[c] : z;
                z += A.b_forget[F.lane];
                const float lf = fminf(z, 0.f) - log1pf(expf(-fabsf(z)));
                const int b = m / SEQ, t = m % SEQ; A.logf[(size_t)(b * NH + F.lane) * SEQ + t] = lf; }
        }
        __syncthreads();
    }
    if (blockIdx.x == 0 && F.tid < 64) { const int l = F.tid; A.gtab[l] = A.g0[l] * QSCALE; A.gtab[64 + l] = A.g1[l]; A.gtab[128 + l] = A.g2[l] * QSCALE; A.gtab[192 + l] = A.g3[l]; }
    for (int idx = (F.vcu * NWAVES * 64) + F.tid; idx < SEQ * 32; idx += F.G * NWAVES * 64) {
        const int pos = idx >> 5, i = idx & 31;
        const float inv_freq = 1.0f / exp2f(((float)(2 * i) / 64.0f) * 13.287712379549449f);
        const float ang = (float)pos * inv_freq;
        const double a = (double)ang; const double k = rint(a * 0.15915494309189535); const float rf = (float)(a - k * 6.283185307179586);
        A.cosT[idx] = cosf(rf); A.sinT[idx] = sinf(rf);
    }
    {
        LAS float* scr = (LAS float*)(F.lds + RING_OFF) + F.wave * (64 * 65);
        constexpr int I_IN = 16 * 48, I_O = 16 * 16, I_G = 16 * 8, I_D = 8 * 16;
        constexpr int NITEMS = I_IN + I_O + NE * (2 * I_G + I_D);
        for (int rep = 0; rep < (REP == 9 ? 2 : 1); ++rep)
        for (int it = gw; it < NITEMS; it += NGW) {
            int r = it;
            if (r < I_IN) { p0_tile(A.w_in, 1024, D_PROJ, 48, A.Win_t, MapWin{}, scr, r, F.lane); continue; } r -= I_IN;
            if (r < I_O) { p0_tile(A.w_out, 1024, 1024, 16, A.Wo_t, MapIdent{0}, scr, r, F.lane); continue; } r -= I_O;
            const int e = r / (2 * I_G + I_D); r -= e * (2 * I_G + I_D);
            if (r < I_G) { p0_tile(A.w_gate + (size_t)e * 1024 * 512, 1024, 512, 8, A.Wgu_t, MapGU{e * 1024}, scr, r, F.lane); continue; } r -= I_G;
            if (r < I_G) { p0_tile(A.w_up + (size_t)e * 1024 * 512, 1024, 512, 8, A.Wgu_t, MapGU{e * 1024 + 128}, scr, r, F.lane); continue; } r -= I_G;
            p0_tile(A.w_down + (size_t)e * 512 * 1024, 512, 1024, 16, A.Wd_t, MapIdent{e * 1024}, scr, r, F.lane);
        }
    }
}
constexpr size_t WS_DILP1 = WS_XN, WS_DILP2 = WS_XN + 16 * MiB;
#ifndef DBGWG
#define DBGWG 0
#endif
struct P2Args { const bf16* qkv; const float* logf; bf16* A2; bf16* dilp1; bf16* dilp2; float* lse; const float* gtab; float* dbgw; };
__device__ __forceinline__ void dil_desc(att::Unit& U, int u, int b, int h, const unsigned short* QA, const P2Args& A) {
    const int pat = u >> 5, blk = u & 31;
    const int dsh = 2 * pat, d = 1 << dsh, bpc = 32 >> dsh, r = blk / bpc, n = blk % bpc;
    U.Q = QA + 3 * QKV_TSTRIDE; U.K = QA + 4 * QKV_TSTRIDE; U.V = QA + 5 * QKV_TSTRIDE;
    U.qrow0 = b * SEQ + r + d * 256 * n; U.qstride = d; U.krow0 = b * SEQ + r + d * (256 * n - 128); U.kstride = d; U.nt0 = (n == 0) ? 2 : 0; U.nt1 = 6; U.ioff = 128; U.W = 128;
    U.bias = nullptr;
    if (pat == 0) { U.O = (unsigned short*)A.A2 + 512 + h * 64; U.opitch = 1024; } else { U.O = (unsigned short*)(pat == 1 ? A.dilp1 : A.dilp2) + h * 64; U.opitch = 512; }
    U.lse = A.lse + (size_t)pat * NT * 8 + h;
}
__device__ __forceinline__ void p2_attention(Frame& F, const P2Args& A, int qsel = 0, int ulo = 0, int uhi = 128) {
    frame_refresh(F);
    const int bh = F.vcu >> 4, b = bh >> 3, h = bh & 7;
    LAS unsigned char* lds = F.lds + RING_OFF;
    LAS float* cbL = (LAS float*)(lds + att::L_CB);
    {
        const float* lf = A.logf + (size_t)bh * SEQ + F.tid * 16;
        float v[16];
#pragma unroll
        for (int j = 0; j < 4; ++j) { const f32x4 x = *(const f32x4*)(lf + 4 * j); v[4 * j] = x.x; v[4 * j + 1] = x.y; v[4 * j + 2] = x.z; v[4 * j + 3] = x.w; }
        double loc = 0.0;
#pragma unroll
        for (int i = 0; i < 16; ++i) loc += (double)v[i];
        double inc = loc;
#pragma unroll
        for (int o = 1; o < 64; o <<= 1) { const double n = __shfl_up(inc, o); if (F.lane >= o) inc += n; }
        LAS double* wtot = (LAS double*)(lds + att::L_WS);
        if (F.lane == 63) wtot[F.wave] = inc;
        __syncthreads();
        double run = inc - loc;
        for (int w = 0; w < F.wave; ++w) run += wtot[w];
#pragma unroll
        for (int i = 0; i < 16; ++i) { run += (double)v[i]; cbL[F.tid * 16 + i] = (float)(-run * (double)LOG2E); }
    }
    float thr;
    { const float mq = wave_max(fabsf(A.gtab[F.lane])), mk = wave_max(fabsf(A.gtab[64 + F.lane])); const float B = 64.0f * mq * mk * 1.02f; thr = -(151.0f + 2.0f * B); if (REP == 10 && qsel == 1) thr = -1e30f; }
    const unsigned short* QA = (const unsigned short*)A.qkv + h * 64;
    LAS int* qs = (LAS int*)(F.lds + QS_OFF);
    gu32* q = F.ctl + CW_QUEUE + (qsel * 16 + bh) * 64;
    if (F.tid == 0) { qs[0] = ulo + (int)__hip_atomic_fetch_add(q, 1u, RLX_AGENT); qs[1] = ulo + (int)__hip_atomic_fetch_add(q, 1u, RLX_AGENT); }
    __syncthreads();
    int cur = qs[0], nxt = qs[1], it = 0;
    unsigned long long dbg[4] = {0, 0, 0, 0}; const unsigned long long p2t0 = DBGSEL ? __builtin_amdgcn_s_memrealtime() : 0ull;
    bool pre_valid = false; att::Pre P;
    while (cur < uhi) {
        int pulled = 0; if (F.tid == 0) pulled = ulo + (int)__hip_atomic_fetch_add(q, 1u, RLX_AGENT);
        if (cur < 32) {
            const int qb = 31 - cur;
            att::Unit U;
            U.Q = QA; U.K = QA + QKV_TSTRIDE; U.V = QA + 2 * QKV_TSTRIDE;
            U.qrow0 = b * SEQ + 256 * qb; U.qstride = 1; U.krow0 = b * SEQ; U.kstride = 1; U.ioff = 256 * qb; U.W = 1 << 30;
            U.bias = cbL; U.O = (unsigned short*)A.A2 + h * 64; U.opitch = 1024; U.lse = nullptr;
            { const float cbt = cbL[256 * qb]; int lo = 0, hi = 4 * qb;
              while (lo < hi) { const int mid = (lo + hi) >> 1; const bool ok = (cbL[64 * mid + 63] - cbt) >= thr; if (__builtin_amdgcn_readfirstlane((int)ok)) hi = mid; else lo = mid + 1; }
              U.nt0 = lo; U.nt1 = 4 * qb + 4; }
            att::fox_unit(U, lds, dbg, pulled, qs + 2 + (it & 1));
        } else {
            att::Unit U; dil_desc(U, cur - 32, b, h, QA, A);
            if (!pre_valid) att::dil_prefetch(P, U);
            att::dil_stage(P, U, lds);
            __syncthreads();
            pre_valid = (nxt >= 32 && nxt < uhi);
            if (pre_valid) { att::Unit Un; dil_desc(Un, nxt - 32, b, h, QA, A); att::dil_prefetch(P, Un); }
            att::dil_compute(U, lds);
            if (F.tid == 0) qs[2 + (it & 1)] = pulled;
            __syncthreads();
        }
        cur = nxt; nxt = qs[2 + (it & 1)]; ++it;
    }
    if (DBGSEL && F.vcu == DBGWG && F.tid == 0 && qsel == 0) {
        const unsigned long long p2t1 = __builtin_amdgcn_s_memrealtime();
        float v = 0.f;
        if (DBGSEL == 1) v = (float)(p2t1 - p2t0);
        if (DBGSEL == 2) v = (float)dbg[0];
        if (DBGSEL == 3) v = (float)dbg[1];
        if (DBGSEL == 4) v = (float)dbg[2];
        if (DBGSEL == 5) v = (float)dbg[3] * 100.0f;
        { const unsigned long long w0 = __builtin_amdgcn_s_memrealtime(); const unsigned long long wt = (unsigned long long)(v * DBGK); while (__builtin_amdgcn_s_memrealtime() - w0 < wt) __builtin_amdgcn_s_sleep(8); }
    }
}
__device__ __forceinline__ float bf_lo(unsigned w) { return __uint_as_float(w << 16); }
__device__ __forceinline__ float bf_hi(unsigned w) { return __uint_as_float(w & 0xffff0000u); }
struct P25Args { bf16* A2; const bf16* dilp1; const bf16* dilp2; const float* lse; const float* gf; const float* gd; };
__device__ __forceinline__ void p25_combine(Frame& F, const P25Args& A) {
    frame_refresh(F);
    const int gw = F.vcu * NWAVES + F.wave, NGW = F.G * NWAVES;
    float ga[8], gb[8];
#pragma unroll
    for (int j = 0; j < 2; ++j) { const f32x4 x = *(const f32x4*)(A.gf + 8 * F.lane + 4 * j), y = *(const f32x4*)(A.gd + 8 * F.lane + 4 * j);
        ga[4 * j] = x.x; ga[4 * j + 1] = x.y; ga[4 * j + 2] = x.z; ga[4 * j + 3] = x.w; gb[4 * j] = y.x; gb[4 * j + 1] = y.y; gb[4 * j + 2] = y.z; gb[4 * j + 3] = y.w; }
    const int head = F.lane >> 3;
    for (int m = gw; m < NT; m += NGW) {
        GAS v4u* rowA = (GAS v4u*)(A.A2 + (size_t)m * 1024) + F.lane;
        const v4u fa = rowA[0], d0 = rowA[64], d1 = *((const GAS v4u*)(A.dilp1 + (size_t)m * 512) + F.lane), d2 = *((const GAS v4u*)(A.dilp2 + (size_t)m * 512) + F.lane);
        const float l0 = A.lse[(size_t)m * 8 + head], l1 = A.lse[(size_t)(NT + m) * 8 + head], l2 = A.lse[(size_t)(2 * NT + m) * 8 + head];
        const float mx = fmaxf(l0, fmaxf(l1, l2));
        float w0 = __builtin_amdgcn_exp2f(l0 - mx), w1 = __builtin_amdgcn_exp2f(l1 - mx), w2 = __builtin_amdgcn_exp2f(l2 - mx);
        const float inv = 1.0f / (w0 + w1 + w2); w0 *= inv; w1 *= inv; w2 *= inv;
        float xa[8], xb[8]; float sa = 0.f, sb = 0.f;
#pragma unroll
        for (int j = 0; j < 4; ++j) {
            xa[2 * j] = bf_lo(fa[j]); xa[2 * j + 1] = bf_hi(fa[j]);
            xb[2 * j] = w0 * bf_lo(d0[j]) + w1 * bf_lo(d1[j]) + w2 * bf_lo(d2[j]); xb[2 * j + 1] = w0 * bf_hi(d0[j]) + w1 * bf_hi(d1[j]) + w2 * bf_hi(d2[j]);
            sa += xa[2 * j] * xa[2 * j] + xa[2 * j + 1] * xa[2 * j + 1]; sb += xb[2 * j] * xb[2 * j] + xb[2 * j + 1] * xb[2 * j + 1];
        }
        const float ra = 1.0f / sqrtf(wave_sum(sa) * (1.0f / 512.0f) + EPS), rb = 1.0f / sqrtf(wave_sum(sb) * (1.0f / 512.0f) + EPS);
        v4u oa, ob;
#pragma unroll
        for (int j = 0; j < 4; ++j) { oa[j] = pk2(xa[2 * j] * ra * ga[2 * j], xa[2 * j + 1] * ra * ga[2 * j + 1]); ob[j] = pk2(xb[2 * j] * rb * gb[2 * j], xb[2 * j + 1] * rb * gb[2 * j + 1]); }
        rowA[0] = oa; rowA[64] = ob;
    }
}
constexpr int CAP = 16384;
constexpr size_t WS_PAIRTOK = WS_WIN;
constexpr size_t WS_PAIRGATE = WS_WIN + 2 * MiB;
constexpr size_t WS_TOKPAIR = WS_ROUTE;
constexpr size_t WS_HN = WS_XN;
constexpr size_t WS_HMID = WS_QKV;
constexpr size_t WS_Y = WS_QKV + 40 * MiB;
static_assert(WS_Y + (size_t)40960 * 1024 * 2 <= WS_END, "ws map");
constexpr int MOE_CNT_OFF = MISC_OFF + 256, MOE_PT_OFF = MOE_CNT_OFF + 128, MOE_LCNT_OFF = MOE_PT_OFF + 256, MOE_LBASE_OFF = MOE_LCNT_OFF + 128, MOE_REC_OFF = MOE_LBASE_OFF + 128;
static_assert(MOE_REC_OFF + 64 * 32 <= LDS_BYTES, "LDS control region");

struct P35Args { const float* h; const float* gffn; const float* wrg; const float* brg; const float* wre; const float* bre; bf16* HN; int* pair_tok; float* pair_gate; int* tok_pair; gu32* gcount; };
__device__ __forceinline__ void p35_router(Frame& F, const P35Args& A) {
    frame_refresh(F);
    LAS float* WrgL = (LAS float*)(F.lds);
    LAS float* WreL = WrgL + 4096;
    LAS int* lcnt = (LAS int*)(F.lds + MOE_LCNT_OFF); LAS int* lbase = (LAS int*)(F.lds + MOE_LBASE_OFF); LAS unsigned* rec = (LAS unsigned*)(F.lds + MOE_REC_OFF);
    for (int k = F.tid; k < 1024; k += NWAVES * 64) {
        const int j = k >> 8, ln = (k & 255) >> 2, i = k & 3, slot = ((j * 4 + i) * 64 + ln) * 4;
        *(LAS f32x4*)(WrgL + slot) = *(const f32x4*)(A.wrg + (size_t)k * 4);
#pragma unroll
        for (int g = 0; g < 4; ++g) { const float* src = A.wre + ((size_t)g * 1024 + k) * 8;
            *(LAS f32x4*)(WreL + (g * 2 + 0) * 4096 + slot) = *(const f32x4*)src; *(LAS f32x4*)(WreL + (g * 2 + 1) * 4096 + slot) = *(const f32x4*)(src + 4); }
    }
    if (F.tid < 32) lcnt[F.tid] = 0;
    __syncthreads();
    f32x4 g4[4];
#pragma unroll
    for (int j = 0; j < 4; ++j) g4[j] = *(const f32x4*)(A.gffn + 4 * F.lane + 256 * j);
    const int tok0 = 64 * F.vcu + 8 * F.wave;
    for (int tt = 0; tt < 8; ++tt) {
        const int tok = tok0 + tt;
        const GAS f32x4* xr = (const GAS f32x4*)(A.h + (size_t)tok * D_MODEL) + F.lane;
        f32x4 v[4]; float ss = 0.f;
#pragma unroll
        for (int j = 0; j < 4; ++j) { v[j] = xr[64 * j]; ss += (v[j].x * v[j].x + v[j].y * v[j].y) + (v[j].z * v[j].z + v[j].w * v[j].w); }
        const float rs = 1.0f / sqrtf(wave_sum(ss) * (1.f / D_MODEL) + EPS);
        GAS unsigned long long* o8 = (GAS unsigned long long*)(A.HN + (size_t)tok * D_MODEL) + F.lane;
        f32x4 zg = (f32x4){0.f, 0.f, 0.f, 0.f};
#pragma unroll
        for (int j = 0; j < 4; ++j) {
            v[j] = v[j] * rs * g4[j];
            o8[64 * j] = (unsigned long long)pk2(v[j].x, v[j].y) | ((unsigned long long)pk2(v[j].z, v[j].w) << 32);
#pragma unroll
            for (int i = 0; i < 4; ++i) zg += v[j][i] * *(const LAS f32x4*)(WrgL + ((j * 4 + i) * 64 + F.lane) * 4);
        }
        float z[4];
#pragma unroll
        for (int g = 0; g < 4; ++g) z[g] = wave_sum(zg[g]) + A.brg[g];
        int gs = 0; float zm = z[0];
#pragma unroll
        for (int g = 1; g < 4; ++g) if (z[g] > zm) { zm = z[g]; gs = g; }
        float den = 0.f;
#pragma unroll
        for (int g = 0; g < 4; ++g) den += expf(z[g] - zm);
        const float pg_top = 1.0f / den;
        gs = __builtin_amdgcn_readfirstlane(gs);
        const LAS float* W0 = WreL + (gs * 2) * 4096; const LAS float* W1 = W0 + 4096;
        f32x4 ea = (f32x4){0.f, 0.f, 0.f, 0.f}, eb = ea;
#pragma unroll
        for (int j = 0; j < 4; ++j)
#pragma unroll
            for (int i = 0; i < 4; ++i) { const int slot = ((j * 4 + i) * 64 + F.lane) * 4; ea += v[j][i] * *(const LAS f32x4*)(W0 + slot); eb += v[j][i] * *(const LAS f32x4*)(W1 + slot); }
        float ze[8];
#pragma unroll
        for (int e = 0; e < 4; ++e) { ze[e] = wave_sum(ea[e]) + A.bre[gs * 8 + e]; ze[4 + e] = wave_sum(eb[e]) + A.bre[gs * 8 + 4 + e]; }
        int i1 = 0; float v1 = ze[0];
#pragma unroll
        for (int e = 1; e < 8; ++e) if (ze[e] > v1) { v1 = ze[e]; i1 = e; }
        int i2 = 0; float v2 = -INFINITY;
#pragma unroll
        for (int e = 0; e < 8; ++e) if (e != i1 && ze[e] > v2) { v2 = ze[e]; i2 = e; }
        const float e2 = expf(v2 - v1); const float g1 = pg_top / (1.0f + e2), g2 = pg_top * e2 / (1.0f + e2);
        if (F.lane == 0) {
            const int ea1 = gs * 8 + i1, ea2 = gs * 8 + i2;
            const int r1 = __hip_atomic_fetch_add(lcnt + ea1, 1, __ATOMIC_RELAXED, __HIP_MEMORY_SCOPE_WORKGROUP), r2 = __hip_atomic_fetch_add(lcnt + ea2, 1, __ATOMIC_RELAXED, __HIP_MEMORY_SCOPE_WORKGROUP);
            LAS unsigned* rc = rec + (8 * F.wave + tt) * 8;
            rc[0] = (unsigned)ea1; rc[1] = (unsigned)ea2; rc[2] = __float_as_uint(g1); rc[3] = __float_as_uint(g2); rc[4] = (unsigned)r1; rc[5] = (unsigned)r2;
        }
    }
    __syncthreads();
    if (F.tid < 32) { const int c = lcnt[F.tid]; lbase[F.tid] = c ? (int)__hip_atomic_fetch_add(A.gcount + F.tid, (unsigned)c, RLX_AGENT) : 0; }
    __syncthreads();
    if (F.tid < 64) {
        const LAS unsigned* rc = rec + F.tid * 8; const int tok = 64 * F.vcu + F.tid;
#pragma unroll
        for (int s = 0; s < 2; ++s) { const int e = (int)rc[s], idx = lbase[e] + (int)rc[4 + s];
            A.pair_tok[e * CAP + idx] = tok; A.pair_gate[e * CAP + idx] = __uint_as_float(rc[2 + s]); A.tok_pair[tok * 2 + s] = (e << 16) | idx; }
    }
}
__device__ __forceinline__ void moe_tables(Frame& F, gu32* gcount) {
    frame_refresh(F);
    LAS int* cnt = (LAS int*)(F.lds + MOE_CNT_OFF); LAS int* pt = (LAS int*)(F.lds + MOE_PT_OFF);
    if (F.tid < 64) {
        const int c = (F.lane < 32) ? (int)__hip_atomic_load(gcount + F.lane, RLX_AGENT) : 0;
        const int tl = (c + 255) >> 8; int inc = tl;
#pragma unroll
        for (int o = 1; o < 32; o <<= 1) { const int n = __shfl_up(inc, o); if (F.lane >= o) inc += n; }
        if (F.lane < 32) { cnt[F.lane] = c; pt[F.lane] = inc - tl; }
        if (F.lane == 31) pt[32] = inc;
    }
    __syncthreads();
}
namespace pg8 {
struct MoeUnit { int e, mt, pn, rows, crow0; };
struct MoeSched {
    typedef MoeUnit UnitT;
    const PG8_LAS int* cnt; const PG8_LAS int* pt; int G, c, nunits;
    __device__ __forceinline__ void init(const PG8_LAS int* cnt_, const PG8_LAS int* pt_, int G_, int c_) { cnt = cnt_; pt = pt_; G = G_; c = c_; nunits = pt_[32] * 4; }
    __device__ __forceinline__ bool next(int i, MoeUnit& u) const {
        const int L = i * G + c; if (L >= nunits) return false;
        int wgid = L; { const int q = nunits / NXCD, r = nunits % NXCD, xcd = wgid % NXCD, off = wgid / NXCD; wgid = (xcd < r ? xcd * (q + 1) : r * (q + 1) + (xcd - r) * q) + off; }
        const int mtg = wgid >> 2; u.pn = wgid & 3;
        int e = 0;
        for (int k = 16; k >= 1; k >>= 1) if (e + k < 32 && pt[e + k] <= mtg) e += k;
        while (e < 31 && pt[e + 1] <= mtg) ++e;
        u.e = e; u.mt = mtg - pt[e]; u.rows = min(256, cnt[e] - 256 * u.mt); u.crow0 = 256 * mtg;
        return true;
    }
};
struct SrcGU {
    const char* A; int K; const int* pair_tok; const char* Bt;
    __device__ __forceinline__ void a_offs(const MoeUnit& u, int R, int C, unsigned (&off)[2]) const {
#pragma unroll
        for (int h = 0; h < 2; ++h) { const int r = h * 128 + R; const int tok = (r < u.rows) ? pair_tok[u.e * CAP + 256 * u.mt + r] : 0; off[h] = (unsigned)(tok * K + C) * 2u; }
    }
    __device__ __forceinline__ const char* b_base(const MoeUnit& u) const { return Bt + ((size_t)u.e * 1024 + 256 * u.pn) * (size_t)K * 2; }
};
struct SrcDown {
    const char* A; int K; const char* Bt;
    __device__ __forceinline__ void a_offs(const MoeUnit& u, int R, int C, unsigned (&off)[2]) const {
#pragma unroll
        for (int h = 0; h < 2; ++h) off[h] = (unsigned)((u.crow0 + h * 128 + R) * K + C) * 2u;
    }
    __device__ __forceinline__ const char* b_base(const MoeUnit& u) const { return Bt + ((size_t)u.e * 1024 + 256 * u.pn) * (size_t)K * 2; }
};
struct EpiGU {
    static constexpr bool PERM = true;
    bf16_t* H;
    __device__ __forceinline__ void operator()(const f32x4 (&acc)[2][2][4][2], const MoeUnit& u, int wr, int wc, int fr_, int fq) const {
        int fr = fr_; asm volatile("" : "+v"(fr));
        const unsigned col0 = (unsigned)(u.pn * 128 + wc * 32 + 8 * fq);
#pragma unroll
        for (int ai = 0; ai < 2; ++ai)
#pragma unroll
            for (int m = 0; m < 4; ++m) { const unsigned r = (unsigned)(u.crow0 + ai * HALF + wr * 64 + m * 16 + fr); float hv[8];
#pragma unroll
                for (int n = 0; n < 2; ++n)
#pragma unroll
                    for (int i = 0; i < 4; ++i) { const float gt = acc[ai][0][m][n][i], up = acc[ai][1][m][n][i];
                        hv[4 * n + i] = gt * __builtin_amdgcn_rcpf(1.0f + __builtin_amdgcn_exp2f(-gt * LOG2E)) * up; }
                u32x4 w; w.x = cvt_pk_bf16(hv[0], hv[1]); w.y = cvt_pk_bf16(hv[2], hv[3]); w.z = cvt_pk_bf16(hv[4], hv[5]); w.w = cvt_pk_bf16(hv[6], hv[7]);
                *(u32x4*)(H + (r * (unsigned)D_EXP + col0)) = w; }
    }
};
struct EpiDown {
    static constexpr bool PERM = true;
    bf16_t* Y; const float* pair_gate;
    __device__ __forceinline__ void operator()(const f32x4 (&acc)[2][2][4][2], const MoeUnit& u, int wr, int wc, int fr_, int fq) const {
        int fr = fr_; asm volatile("" : "+v"(fr));
        const unsigned col0 = (unsigned)(u.pn * BM + wc * 32 + 8 * fq);
        const float* gp = pair_gate + (u.e * CAP + 256 * u.mt);
#pragma unroll
        for (int ai = 0; ai < 2; ++ai)
#pragma unroll
            for (int m = 0; m < 4; ++m) { const int rl = ai * HALF + wr * 64 + m * 16 + fr; const unsigned off = (unsigned)(u.crow0 + rl) * (unsigned)D_MODEL + col0;
                const float gt = (rl < u.rows) ? gp[rl] : 0.f;
#pragma unroll
                for (int bj = 0; bj < 2; ++bj) { const f32x4 v0 = acc[ai][bj][m][0] * gt, v1 = acc[ai][bj][m][1] * gt;
                    u32x4 w; w.x = cvt_pk_bf16(v0[0], v0[1]); w.y = cvt_pk_bf16(v0[2], v0[3]); w.z = cvt_pk_bf16(v1[0], v1[1]); w.w = cvt_pk_bf16(v1[2], v1[3]);
                    *(u32x4*)(Y + (off + (unsigned)(bj * HALF))) = w; } }
    }
};
}
struct P6Args { float* out; const bf16* Y; const int* tok_pair; const float* dbgw; };
__device__ __forceinline__ void p6_final(Frame& F, const P6Args& A) {
    frame_refresh(F);
    const LAS int* pt = (const LAS int*)(F.lds + MOE_PT_OFF);
    const int gw = F.vcu * NWAVES + F.wave, NGW = F.G * NWAVES;
    for (int m = gw; m < NT; m += NGW) {
        const int p1 = A.tok_pair[m * 2], p2 = A.tok_pair[m * 2 + 1];
        const size_t r1 = (size_t)(256 * pt[p1 >> 16] + (p1 & 0xffff)), r2 = (size_t)(256 * pt[p2 >> 16] + (p2 & 0xffff));
        GAS f32x4* orow = (GAS f32x4*)(A.out + (size_t)m * D_MODEL) + F.lane;
        const GAS unsigned long long* y1 = (const GAS unsigned long long*)(A.Y + r1 * D_MODEL) + F.lane; const GAS unsigned long long* y2 = (const GAS unsigned long long*)(A.Y + r2 * D_MODEL) + F.lane;
#pragma unroll
        for (int j = 0; j < 4; ++j) { f32x4 o = orow[64 * j]; const unsigned long long a = y1[64 * j], b = y2[64 * j];
            const unsigned a0 = (unsigned)a, a1 = (unsigned)(a >> 32), b0 = (unsigned)b, b1 = (unsigned)(b >> 32);
            o.x += bf_lo(a0) + bf_lo(b0); o.y += bf_hi(a0) + bf_hi(b0); o.z += bf_lo(a1) + bf_lo(b1); o.w += bf_hi(a1) + bf_hi(b1);
            orow[64 * j] = o; }
    }
}
struct Args { const float* in[19]; float* out; unsigned char* ws; };
__global__ void __launch_bounds__(NWAVES * 64, 2) mk_fwd(Args args) {
    extern __shared__ __attribute__((aligned(16))) unsigned char lds[];
    Frame F;
    F.lds = (LAS unsigned char*)lds;
    F.MISC = (volatile LAS unsigned*)(F.lds + MISC_OFF);
    F.tid = threadIdx.x; F.lane = F.tid & 63; F.wave = __builtin_amdgcn_readfirstlane(F.tid >> 6);
    F.G = gridDim.x; { const int bx = blockIdx.x; F.vcu = (F.G % 8 == 0) ? (bx % 8) * (F.G / 8) + bx / 8 : bx; }
    unsigned char* ws = args.ws;
    F.ctl = (gu32*)(ws + WS_CTL);
    for (int u = F.tid; u < (LDS_BYTES - LDSCTL_OFF) / 4; u += NWAVES * 64) ((LAS unsigned*)(F.lds + LDSCTL_OFF))[u] = 0u;
    __syncthreads();
    XcdBarrier bar = xcd_barrier_post((unsigned*)(F.ctl + CW_BAR), F.MISC + 8);
#define STAMP(k) do { if (DBGSEL >= 100 && blockIdx.x == 0 && threadIdx.x == 0) ((volatile LAS unsigned long long*)(F.lds + STAMP_OFF))[k] = __builtin_amdgcn_s_memrealtime(); } while (0)
    STAMP(0);

    {
        P0Args A{args.in[0], args.in[1], args.in[2], args.in[3], args.in[10], args.in[16], args.in[17], args.in[18],
                 (bf16*)(ws + WS_WIN), (bf16*)(ws + WS_WO), (bf16*)(ws + WS_WGU), (bf16*)(ws + WS_WD), (bf16*)(ws + WS_XN), (float*)(ws + WS_LOGF), (float*)(ws + WS_ROPE), (float*)(ws + WS_ROPE) + SEQ * 32,
                 args.in[4], args.in[5], args.in[6], args.in[7], (float*)(ws + WS_GTAB)};
        for (int rep = 0; rep < (REP == 1 ? 2 : 1); ++rep) p0_prologue(F, A);
    }
    STAMP(1);
    xcd_barrier(bar);
    STAMP(2);
    {
        pg8::Gemm g{(const pg8::bf16_t*)(ws + WS_XN), (const pg8::bf16_t*)(ws + WS_WIN), NT, NQKV, D_MODEL};
        pg8::StaticOrder S; S.init(NT, NQKV, F.G, (int)blockIdx.x);
        pg8::EpiQKV E{(pg8::bf16_t*)(ws + WS_QKV), (const float*)(ws + WS_GTAB), (const float*)(ws + WS_ROPE), (const float*)(ws + WS_ROPE) + SEQ * 32};
        for (int rep = 0; rep < (REP == 2 ? 2 : 1); ++rep) pg8::gemm_phase<pg8::EpiQKV, pg8::StaticOrder, true, true>(F.lds + RING_OFF, g, S, E);
    }
    STAMP(3);
    xcd_barrier(bar);
    STAMP(4);
    {
        P2Args A{(const bf16*)(ws + WS_QKV), (const float*)(ws + WS_LOGF), (bf16*)(ws + WS_A2), (bf16*)(ws + WS_DILP1), (bf16*)(ws + WS_DILP2), (float*)(ws + WS_LSE), (const float*)(ws + WS_GTAB), (float*)(ws + WS_CTL + 64 * KiB)};
        p2_attention(F, A);
        if (REP == 3 || REP == 10) { __syncthreads(); p2_attention(F, A, 1, 0, 32); }
        if (REP == 4) { __syncthreads(); p2_attention(F, A, 1, 32, 128); }
    }
    STAMP(5);
    xcd_barrier(bar);
    STAMP(6);
    {
        P25Args A{(bf16*)(ws + WS_A2), (const bf16*)(ws + WS_DILP1), (const bf16*)(ws + WS_DILP2), (const float*)(ws + WS_LSE), args.in[8], args.in[9]};
        p25_combine(F, A);
    }
    STAMP(7);
    xcd_barrier(bar);
    STAMP(8);
    {
        pg8::Gemm g{(const pg8::bf16_t*)(ws + WS_A2), (const pg8::bf16_t*)(ws + WS_WO), NT, D_MODEL, D_MODEL};
        pg8::StaticOrder S; S.init(NT, D_MODEL, F.G, (int)blockIdx.x);
        pg8::EpiRes E{args.in[0], args.out};
        for (int rep = 0; rep < (REP == 5 ? 2 : 1); ++rep) pg8::gemm_phase<pg8::EpiRes, pg8::StaticOrder, true, true>(F.lds + RING_OFF, g, S, E);
    }
    STAMP(9);
    xcd_barrier(bar);
    STAMP(10);
    {
        P35Args A{args.out, args.in[11], args.in[12], args.in[13], args.in[14], args.in[15], (bf16*)(ws + WS_HN), (int*)(ws + WS_PAIRTOK), (float*)(ws + WS_PAIRGATE), (int*)(ws + WS_TOKPAIR), F.ctl + CW_COUNT};
        p35_router(F, A);
    }
    STAMP(11);
    xcd_barrier(bar);
    STAMP(12);
    moe_tables(F, F.ctl + CW_COUNT);
    {
        pg8::MoeSched S; S.init((const LAS int*)(F.lds + MOE_CNT_OFF), (const LAS int*)(F.lds + MOE_PT_OFF), F.G, (int)blockIdx.x);
        pg8::SrcGU X{(const char*)(ws + WS_HN), D_MODEL, (const int*)(ws + WS_PAIRTOK), (const char*)(ws + WS_WGU)};
        pg8::EpiGU E{(pg8::bf16_t*)(ws + WS_HMID)};
        for (int rep = 0; rep < (REP == 6 ? 2 : 1); ++rep) pg8::gemm_phase2<pg8::EpiGU, pg8::MoeSched, pg8::SrcGU>(F.lds + RING_OFF, S, X, E);
    }
    STAMP(13);
    xcd_barrier(bar);
    STAMP(14);
    {
        pg8::MoeSched S; S.init((const LAS int*)(F.lds + MOE_CNT_OFF), (const LAS int*)(F.lds + MOE_PT_OFF), F.G, (int)blockIdx.x);
        pg8::SrcDown X{(const char*)(ws + WS_HMID), D_EXP, (const char*)(ws + WS_WD)};
        pg8::EpiDown E{(pg8::bf16_t*)(ws + WS_Y), (const float*)(ws + WS_PAIRGATE)};
        for (int rep = 0; rep < (REP == 7 ? 2 : 1); ++rep) pg8::gemm_phase2<pg8::EpiDown, pg8::MoeSched, pg8::SrcDown>(F.lds + RING_OFF, S, X, E);
    }
    STAMP(15);
    xcd_barrier(bar);
    STAMP(16);
    {
        P6Args A{args.out, (const bf16*)(ws + WS_Y), (const int*)(ws + WS_TOKPAIR), (const float*)(ws + WS_CTL + 64 * KiB)};
        p6_final(F, A);
    }
    STAMP(17);
    if (DBGSEL >= 100 && blockIdx.x == 0 && threadIdx.x == 0) {
        volatile LAS unsigned long long* st = (volatile LAS unsigned long long*)(F.lds + STAMP_OFF);
        unsigned long long d = 0;
        if (DBGSEL >= 200) { for (int i = 1; i < 17; i += 2) d += st[i + 1] - st[i]; } else d = st[(DBGSEL - 100 + 1) & 31] - st[(DBGSEL - 100) & 31];
        const unsigned long long w0 = __builtin_amdgcn_s_memrealtime(); const unsigned long long wt = (unsigned long long)((float)d * DBGK);
        while (__builtin_amdgcn_s_memrealtime() - w0 < wt) __builtin_amdgcn_s_sleep(8);
    }
}
extern "C" void kernel_launch(void* const* d_in, const int* in_sizes, int n_in, void* d_out, int out_size, void* d_ws, size_t ws_size, hipStream_t stream) {
    static int grid = 0;
    if (grid == 0) {
        if (n_in != 19 || ws_size < WS_END) { fprintf(stderr, "kernel_launch: bad arguments (n_in %d, ws %zu)\n", n_in, ws_size); grid = -1; return; }
        int dev = 0, cus = 0;
        if (hipGetDevice(&dev) != hipSuccess || hipDeviceGetAttribute(&cus, hipDeviceAttributeMultiprocessorCount, dev) != hipSuccess) { grid = -1; return; }
        if (hipFuncSetAttribute((const void*)mk_fwd, hipFuncAttributeMaxDynamicSharedMemorySize, LDS_BYTES) != hipSuccess) { fprintf(stderr, "kernel_launch: hipFuncSetAttribute failed\n"); grid = -1; return; }
        int per_cu = 0;
        if (hipOccupancyMaxActiveBlocksPerMultiprocessor(&per_cu, (const void*)mk_fwd, NWAVES * 64, LDS_BYTES) != hipSuccess || per_cu < 1) fprintf(stderr, "kernel_launch: occupancy query says %d\n", per_cu);
        (void)hipGetLastError();
        grid = cus;
        if (grid != 256) { fprintf(stderr, "kernel_launch: this build needs 256 CUs (got %d)\n", cus); grid = -1; return; }
    }
    if (grid < 0) return;
    char* ws = (char*)d_ws; float* out = (float*)d_out;
    (void)hipMemsetAsync(ws + WS_CTL, 0, CTL_ZERO_BYTES, stream);
    Args a{};
    for (int i = 0; i < 19; ++i) a.in[i] = (const float*)d_in[i];
    a.out = out; a.ws = (unsigned char*)d_ws;
    hipLaunchKernelGGL(mk_fwd, dim3(grid), dim3(NWAVES * 64), LDS_BYTES, stream, a);
}
```
